# Optimizing an MI355X kernel written in HIP

```python
import jax, jax.numpy as jnp
from jax import lax
import numpy as np

D_MODEL = 1024
BATCH = 4
SEQ = 8192
DEPTH = 1

CHUNK = 64
Q_BLOCK = 128
FOX_HEAD_DIM = 128
N_FOX_HEADS = D_MODEL // FOX_HEAD_DIM
FOX_WIDTH = N_FOX_HEADS * FOX_HEAD_DIM
SGU_GROUP_DIM = 128
N_SGU_GROUPS = D_MODEL // SGU_GROUP_DIM
SGU_WIDTH = N_SGU_GROUPS * SGU_GROUP_DIM
SGU_LEN = 128
D_FF = 4 * D_MODEL
RMS_EPS = 1e-6
LN_EPS = 1e-5

COL_Q = 0
COL_K = COL_Q + FOX_WIDTH
COL_V = COL_K + FOX_WIDTH
COL_F = COL_V + FOX_WIDTH
COL_U = COL_F + N_FOX_HEADS
COL_SV = COL_U + SGU_WIDTH
COL_GA = COL_SV + SGU_WIDTH
COL_GB = COL_GA + D_MODEL
IN_WIDTH = COL_GB + D_MODEL

kernel_name = "fox_gmlp_gated_macaron_block"


def rmsnorm(x, g):
    xf = x.astype(jnp.float32)
    y = xf * lax.rsqrt(jnp.mean(xf * xf, axis=-1, keepdims=True) + RMS_EPS)
    return (y * g.astype(jnp.float32)).astype(x.dtype)


def swiglu(h, w_gate, w_up, w_down):
    return (jax.nn.silu(h @ w_gate) * (h @ w_up)) @ w_down


def forgetting_attention(q, k, v, f_logit, b_forget):
    B, S, H, D = q.shape
    nb = S // Q_BLOCK
    scale = 1.0 / np.sqrt(D).astype(np.float32)
    log_f = jax.nn.log_sigmoid(f_logit.astype(jnp.float32) + b_forget.astype(jnp.float32))
    c = jnp.cumsum(log_f, axis=1).transpose(0, 2, 1)
    kh = k.transpose(0, 2, 1, 3)
    vh = v.transpose(0, 2, 1, 3)
    qb = q.transpose(0, 2, 1, 3).reshape(B, H, nb, Q_BLOCK, D).transpose(2, 0, 1, 3, 4)
    cb = c.reshape(B, H, nb, Q_BLOCK).transpose(2, 0, 1, 3)
    k_pos = jnp.arange(S)

    def block(args):
        q_blk, c_blk, idx = args
        s = jnp.einsum('bhqd,bhkd->bhqk', q_blk, kh).astype(jnp.float32) * scale
        s = s + c_blk[..., :, None] - c[:, :, None, :]
        q_pos = idx * Q_BLOCK + jnp.arange(Q_BLOCK)
        s = jnp.where(k_pos[None, :] <= q_pos[:, None], s, -jnp.inf)
        p = jax.nn.softmax(s, axis=-1).astype(vh.dtype)
        return jnp.einsum('bhqk,bhkd->bhqd', p, vh)

    out = lax.map(block, (qb, cb, jnp.arange(nb)))
    return out.transpose(1, 0, 3, 2, 4).reshape(B, S, H * D)


def spatial_gating(u, v, ln_g, ln_b, w_s, b_s):
    B, S, W = v.shape
    G, C, L = N_SGU_GROUPS, SGU_GROUP_DIM, SGU_LEN
    vf = v.astype(jnp.float32).reshape(B, S, G, C)
    mu = jnp.mean(vf, axis=-1, keepdims=True)
    var = jnp.mean(jnp.square(vf - mu), axis=-1, keepdims=True)
    vn = ((vf - mu) * lax.rsqrt(var + LN_EPS)).reshape(B, S, W)
    vn = (vn * ln_g.astype(jnp.float32) + ln_b.astype(jnp.float32)).reshape(B, S // L, L, G, C)
    pos = jnp.arange(L)
    mask = (pos[None, :] // CHUNK) <= (pos[:, None] // CHUNK)
    w = jnp.where(mask[None], w_s.astype(jnp.float32), 0.0)
    mixed = jnp.einsum('gts,bnsgc->bntgc', w, vn) + b_s.astype(jnp.float32).T[None, None, :, :, None]
    return u * mixed.reshape(B, S, W).astype(u.dtype)


def setup_inputs(seed: int = 0) -> dict:
    key = jax.random.key(seed)
    ks = jax.random.split(key, 24)
    L, D, F = DEPTH, D_MODEL, D_FF
    nrm = lambda k, shape, fan_in: jax.random.normal(k, shape, jnp.float32) * (fan_in ** -0.5)
    gain = lambda k, shape: 1.0 + 0.05 * jax.random.normal(k, shape, jnp.float32)
    return {
        "x": jax.random.normal(ks[0], (BATCH, SEQ, D), jnp.float32),
        "ffn1_pre_g": gain(ks[1], (L, D)),
        "ffn1_w_gate": nrm(ks[2], (L, D, F), D),
        "ffn1_w_up": nrm(ks[3], (L, D, F), D),
        "ffn1_w_down": nrm(ks[4], (L, F, D), F),
        "ffn1_post_g": gain(ks[5], (L, D)),
        "mix_pre_g": gain(ks[6], (L, D)),
        "w_in": nrm(ks[7], (L, D, IN_WIDTH), D),
        "b_forget": jax.random.uniform(ks[8], (L, N_FOX_HEADS), jnp.float32, 2.0, 6.0),
        "sgu_ln_g": gain(ks[9], (L, SGU_WIDTH)),
        "sgu_ln_b": 0.02 * jax.random.normal(ks[10], (L, SGU_WIDTH), jnp.float32),
        "sgu_w_s": nrm(ks[11], (L, N_SGU_GROUPS, SGU_LEN, SGU_LEN), SGU_LEN),
        "sgu_b_s": 1.0 + 0.02 * jax.random.normal(ks[12], (L, N_SGU_GROUPS, SGU_LEN), jnp.float32),
        "w_out": nrm(ks[13], (L, D, D), D),
        "mix_post_g": gain(ks[14], (L, D)),
        "ffn2_pre_g": gain(ks[15], (L, D)),
        "ffn2_w_gate": nrm(ks[16], (L, D, F), D),
        "ffn2_w_up": nrm(ks[17], (L, D, F), D),
        "ffn2_w_down": nrm(ks[18], (L, F, D), F),
        "ffn2_post_g": gain(ks[19], (L, D)),
    }


def reference(x, ffn1_pre_g, ffn1_w_gate, ffn1_w_up, ffn1_w_down, ffn1_post_g,
              mix_pre_g, w_in, b_forget, sgu_ln_g, sgu_ln_b, sgu_w_s, sgu_b_s,
              w_out, mix_post_g, ffn2_pre_g, ffn2_w_gate, ffn2_w_up, ffn2_w_down,
              ffn2_post_g):
    B, S, D = x.shape
    H, HD = N_FOX_HEADS, FOX_HEAD_DIM
    for l in range(DEPTH):
        h = rmsnorm(x, ffn1_pre_g[l])
        x = x + 0.5 * rmsnorm(swiglu(h, ffn1_w_gate[l], ffn1_w_up[l], ffn1_w_down[l]), ffn1_post_g[l])

        h = rmsnorm(x, mix_pre_g[l])
        z = h @ w_in[l]
        q = z[..., COL_Q:COL_K].reshape(B, S, H, HD)
        k = z[..., COL_K:COL_V].reshape(B, S, H, HD)
        v = z[..., COL_V:COL_F].reshape(B, S, H, HD)
        f_logit = z[..., COL_F:COL_U]
        u_s = jax.nn.gelu(z[..., COL_U:COL_SV], approximate=False)
        v_s = jax.nn.gelu(z[..., COL_SV:COL_GA], approximate=False)
        gate_a = jax.nn.sigmoid(z[..., COL_GA:COL_GB])
        gate_b = jax.nn.sigmoid(z[..., COL_GB:IN_WIDTH])

        o_a = forgetting_attention(q, k, v, f_logit, b_forget[l])
        o_b = spatial_gating(u_s, v_s, sgu_ln_g[l], sgu_ln_b[l], sgu_w_s[l], sgu_b_s[l])
        merged = gate_a * o_a + gate_b * o_b
        x = x + rmsnorm(merged @ w_out[l], mix_post_g[l])

        h = rmsnorm(x, ffn2_pre_g[l])
        x = x + 0.5 * rmsnorm(swiglu(h, ffn2_w_gate[l], ffn2_w_up[l], ffn2_w_down[l]), ffn2_post_g[l])
    return x
```

```cpp
#include <hip/hip_runtime.h>
#include <hip/hip_cooperative_groups.h>
#include <hip/hip_bf16.h>
#include <cstdio>
#include <cstdint>
namespace cg = cooperative_groups;
namespace pg8 {
#define PG8_LAS __attribute__((address_space(3)))
typedef unsigned short bf16_t;
typedef short bf16x8 __attribute__((ext_vector_type(8)));
typedef float f32x4 __attribute__((ext_vector_type(4)));
typedef unsigned u32x4 __attribute__((ext_vector_type(4)));
constexpr int BM = 256, BK = 64, HALF = 128, HTB = HALF * BK * 2  , STAGE_BYTES = 8 * HTB, NXCD = 8, WGM = 8;

__host__ __device__ __forceinline__ int lds_byte(int r, int c) { const int st = (r >> 4) * 2 + (c >> 5), rr = r & 15, cc = c & 31, ob = rr * 64 + cc * 2; return st * 1024 + (ob ^ (((ob >> 9) & 1) << 5)); }
__host__ __device__ __forceinline__ void stage_rc(int b, int& R, int& C) { const int st = b / 1024, sb = b % 1024, swz = sb ^ (((sb >> 9) & 1) << 5); R = (st >> 1) * 16 + swz / 64; C = (st & 1) * 32 + (swz % 64) / 2; }
__host__ __device__ __forceinline__ int perm32(int rho) { const int n = rho >> 4, i = rho & 15; return 8 * (i >> 2) + 4 * n + (i & 3); }

struct Unit { int pm, pn; };
struct Gemm { const bf16_t* A; const bf16_t* Bt; int M, N, K; };

struct StaticOrder {
    int nM, nN, nwg, G, c;
    __host__ __device__ void init(int M, int N, int G_, int c_) { nM = M / BM; nN = N / BM; nwg = nM * nN; G = G_; c = c_; }
    __host__ __device__ bool next(int i, Unit& u) const {
        const long L = (long)i * G + c; if (L >= nwg) return false;
        int wgid = (int)L; { const int q = nwg / NXCD, r = nwg % NXCD, xcd = wgid % NXCD, off = wgid / NXCD; wgid = (xcd < r ? xcd * (q + 1) : r * (q + 1) + (xcd - r) * q) + off; }
        const int nig = WGM * nN, gid = wgid / nig, fm = gid * WGM, gsz = (nM - fm) < WGM ? (nM - fm) : WGM;
        u.pm = fm + ((wgid % nig) % gsz); u.pn = (wgid % nig) / gsz; return true;
    }
    __device__ __forceinline__ void a_ready(const Unit&) const {}
    __device__ __forceinline__ void done(const Unit&) const {}
};

typedef float cvt_f32x2 __attribute__((ext_vector_type(2))); typedef __bf16 cvt_bf16x2 __attribute__((ext_vector_type(2)));
__device__ __forceinline__ unsigned cvt_pk_bf16(float lo, float hi) { cvt_f32x2 v = {lo, hi}; cvt_bf16x2 b = __builtin_convertvector(v, cvt_bf16x2); return __builtin_bit_cast(unsigned, b); }
typedef float f32x2 __attribute__((ext_vector_type(2)));
__device__ __forceinline__ f32x2 gelu_pk(f32x2 v) {
    const f32x2 av = __builtin_elementwise_abs(v), d = av * 0.2316418882f + 1.0f;
    f32x2 t; t.x = __builtin_amdgcn_rcpf(d.x); t.y = __builtin_amdgcn_rcpf(d.y);
    f32x2 q = t * 0.5307027145f + (-0.7265760135f); q = q * t + 0.7107068705f; q = q * t + (-0.142248368f); q = q * t + 0.127414796f; q = q * t;
    const f32x2 s = (v * v) * (-0.72134752044f);
    f32x2 e; e.x = __builtin_amdgcn_exp2f(s.x); e.y = __builtin_amdgcn_exp2f(s.y);
    const f32x2 m = v * (q * e), r = v - m;
    f32x2 o; o.x = v.x < 0.f ? m.x : r.x; o.y = v.y < 0.f ? m.y : r.y; return o;
}

template <int ACT  > struct EpiBf16 {
    static constexpr bool PERM = true, AFTER_DRAIN = false, RSTD_LDS = false; static_assert(ACT == 0 || ACT == 1, "EpiBf16: ACT is 0 (none) or 1 (gelu_pk)");
    bf16_t* O; int ldc; const float* bias; int split_cols; size_t split_stride; float scale0;
    __device__ __forceinline__ void operator()(const f32x4 (&acc)[2][2][4][2], const Unit& u, int wr, int wc, int fr, int fq) const {
        const int row0 = u.pm * BM + wr * 64 + fr; int colt = u.pn * BM; bf16_t* base = O;
        float sc = 1.f; if (split_cols) { const int t = colt / split_cols; base += (size_t)t * split_stride; colt -= t * split_cols; if (t == 0) sc = scale0; }
        const int col0 = colt + wc * 32 + 8 * fq, bcol0 = u.pn * BM + wc * 32 + 8 * fq;
        f32x4 bv[2][2];
#pragma unroll
        for (int bj = 0; bj < 2; ++bj)
#pragma unroll
            for (int n = 0; n < 2; ++n) bv[bj][n] = bias ? *(const f32x4*)(bias + bcol0 + bj * HALF + 4 * n) : (f32x4){0.f, 0.f, 0.f, 0.f};
#pragma unroll
        for (int ai = 0; ai < 2; ++ai)
#pragma unroll
            for (int m = 0; m < 4; ++m) { bf16_t* rowp = base + (size_t)(row0 + ai * HALF + m * 16) * ldc + col0;
#pragma unroll
                for (int bj = 0; bj < 2; ++bj) { f32x4 v0 = acc[ai][bj][m][0] + bv[bj][0], v1 = acc[ai][bj][m][1] + bv[bj][1];
                    if (ACT == 1) { f32x2 a = gelu_pk((f32x2){v0[0], v0[1]}), b = gelu_pk((f32x2){v0[2], v0[3]}), c = gelu_pk((f32x2){v1[0], v1[1]}), d = gelu_pk((f32x2){v1[2], v1[3]});
                        v0 = (f32x4){a.x, a.y, b.x, b.y}; v1 = (f32x4){c.x, c.y, d.x, d.y}; }
                    v0 = v0 * sc; v1 = v1 * sc; u32x4 w; w.x = cvt_pk_bf16(v0[0], v0[1]); w.y = cvt_pk_bf16(v0[2], v0[3]); w.z = cvt_pk_bf16(v1[0], v1[1]); w.w = cvt_pk_bf16(v1[2], v1[3]);
                    *(u32x4*)(rowp + bj * HALF) = w; } }
    }
};

__device__ __forceinline__ float sigmoid_f(float x) { return __builtin_amdgcn_rcpf(1.0f + __builtin_amdgcn_exp2f(-1.4426950408889634f * x)); }
struct EpiSwiGLU {
    static constexpr bool PERM = true, AFTER_DRAIN = false, RSTD_LDS = true;
    bf16_t* O; const float* rstd;
    __device__ __forceinline__ void operator()(const f32x4 (&acc)[2][2][4][2], const Unit& u, int wr, int wc, int fr, int fq, const PG8_LAS float* rl) const {
        const int row0 = u.pm * BM + wr * 64 + fr, col0 = u.pn * HALF + wc * 32 + 8 * fq; rl += wr * 64 + fr;
#pragma unroll
        for (int ai = 0; ai < 2; ++ai)
#pragma unroll
            for (int m = 0; m < 4; ++m) { const int row = row0 + ai * HALF + m * 16; const float rs = rl[ai * HALF + m * 16];
                u32x4 w; unsigned wv[4];
#pragma unroll
                for (int n = 0; n < 2; ++n) { const f32x4 g = acc[ai][0][m][n] * rs, up = acc[ai][1][m][n] * rs; float o[4];
#pragma unroll
                    for (int j = 0; j < 4; ++j) o[j] = g[j] * sigmoid_f(g[j]) * up[j];
                    wv[2 * n] = cvt_pk_bf16(o[0], o[1]); wv[2 * n + 1] = cvt_pk_bf16(o[2], o[3]); }
                w.x = wv[0]; w.y = wv[1]; w.z = wv[2]; w.w = wv[3];
                *(u32x4*)(O + (size_t)row * 4096 + col0) = w; }
    }
};
struct EpiMix {
    static constexpr bool PERM = true, AFTER_DRAIN = false, RSTD_LDS = true;
    bf16_t* O; size_t stride; int mode; const float* rstd;
    unsigned* nrm;
    template <int ACT> __device__ __forceinline__ void body(const f32x4 (&acc)[2][2][4][2], bf16_t* base, int row0, int col0, const PG8_LAS float* rl) const {
#pragma unroll
        for (int ai = 0; ai < 2; ++ai)
#pragma unroll
            for (int m = 0; m < 4; ++m) { const int row = row0 + ai * HALF + m * 16; const float rs = rl[ai * HALF + m * 16]; bf16_t* rowp = base + (size_t)row * 1024 + col0;
#pragma unroll
                for (int bj = 0; bj < 2; ++bj) { f32x4 v0 = acc[ai][bj][m][0] * rs, v1 = acc[ai][bj][m][1] * rs;
                    if (ACT == 1) { f32x2 a = gelu_pk((f32x2){v0[0], v0[1]}), b = gelu_pk((f32x2){v0[2], v0[3]}), c = gelu_pk((f32x2){v1[0], v1[1]}), d = gelu_pk((f32x2){v1[2], v1[3]});
                        v0 = (f32x4){a.x, a.y, b.x, b.y}; v1 = (f32x4){c.x, c.y, d.x, d.y}; }
                    if (ACT == 2) {
#pragma unroll
                        for (int j = 0; j < 4; ++j) { v0[j] = sigmoid_f(v0[j]); v1[j] = sigmoid_f(v1[j]); } }
                    u32x4 w; w.x = cvt_pk_bf16(v0[0], v0[1]); w.y = cvt_pk_bf16(v0[2], v0[3]); w.z = cvt_pk_bf16(v1[0], v1[1]); w.w = cvt_pk_bf16(v1[2], v1[3]);
                    *(u32x4*)(rowp + bj * HALF) = w; } }
    }
    __device__ __forceinline__ void operator()(const f32x4 (&acc)[2][2][4][2], const Unit& u, int wr, int wc, int fr, int fq, const PG8_LAS float* rl) const {
        rl += wr * 64 + fr;
        const int t = (u.pn * BM) >> 10, colt = u.pn * BM - (t << 10);
        bf16_t* base = O + (size_t)t * stride; const int a = mode == 0 ? (t < 2 ? 1 : 2) : (t == 3 ? 2 : 0);
        const int row0 = u.pm * BM + wr * 64 + fr, col0 = colt + wc * 32 + 8 * fq;
        if (a == 0) body<0>(acc, base, row0, col0, rl); else if (a == 1) body<1>(acc, base, row0, col0, rl); else body<2>(acc, base, row0, col0, rl);
        if (mode == 1 && (t == 0 || t == 2)) {
            float mx[2] = {0.f, 0.f};
#pragma unroll
            for (int ai = 0; ai < 2; ++ai)
#pragma unroll
                for (int m = 0; m < 4; ++m) { const float rs = rl[ai * HALF + m * 16];
#pragma unroll
                    for (int bj = 0; bj < 2; ++bj) { const f32x4 v0 = acc[ai][bj][m][0] * rs, v1 = acc[ai][bj][m][1] * rs;
                        float s = (v0[0] * v0[0] + v0[1] * v0[1]) + (v0[2] * v0[2] + v0[3] * v0[3]) + (v1[0] * v1[0] + v1[1] * v1[1]) + (v1[2] * v1[2] + v1[3] * v1[3]);
                        s += __int_as_float(__builtin_amdgcn_ds_swizzle(__float_as_int(s), (16 << 10) | 0x1f));
                        { auto rr = __builtin_amdgcn_permlane32_swap(__float_as_uint(s), __float_as_uint(s), false, false); s = __uint_as_float(rr[0]) + __uint_as_float(rr[1]); }
                        mx[bj] = fmaxf(mx[bj], s); } }
#pragma unroll
            for (int bj = 0; bj < 2; ++bj) { float v = mx[bj];
                v = fmaxf(v, __int_as_float(__builtin_amdgcn_ds_swizzle(__float_as_int(v), (1 << 10) | 0x1f))); v = fmaxf(v, __int_as_float(__builtin_amdgcn_ds_swizzle(__float_as_int(v), (2 << 10) | 0x1f)));
                v = fmaxf(v, __int_as_float(__builtin_amdgcn_ds_swizzle(__float_as_int(v), (4 << 10) | 0x1f))); v = fmaxf(v, __int_as_float(__builtin_amdgcn_ds_swizzle(__float_as_int(v), (8 << 10) | 0x1f)));
                mx[bj] = v; }
            if (fr == 0 && fq == 0) { const int b = u.pm >> 5;
#pragma unroll
                for (int bj = 0; bj < 2; ++bj) { const int bh = b * 8 + (u.pn & 3) * 2 + bj; atomicMax(nrm + ((bh * 2 + (t == 0 ? 1 : 0)) * 4 + wc), __float_as_uint(mx[bj])); } }
        }
    }
};
template <class Epi, class Sched, bool ALIGN_EPI = false, bool SP2 = false>
__device__ __forceinline__ void gemm_phase(PG8_LAS unsigned char* lds, const Gemm g, const Sched& S, const Epi& E, int wave_s) {
    int tid = 0; asm volatile("" : "+v"(tid)); tid = wave_s * 64 + (int)__builtin_amdgcn_mbcnt_hi(~0u, __builtin_amdgcn_mbcnt_lo(~0u, (unsigned)tid)); asm volatile("" : "+v"(tid));
    const int wid = __builtin_amdgcn_readfirstlane(tid >> 6), lane = tid & 63, wr = wid >> 2, wc = wid & 3, fr = lane & 15, fq = lane >> 4;
    const int K = g.K, nt = K / BK;
    unsigned voffA[2], voffB[2];
#pragma unroll
    for (int i = 0; i < 2; ++i) { int R, C; stage_rc(tid * 16 + i * 8192, R, C); const int Rb = Epi::PERM ? ((R & ~31) + perm32(R & 31)) : R;
        voffA[i] = (unsigned)(R * K + C) * 2u; voffB[i] = (unsigned)(Rb * K + C) * 2u; }
    const size_t kstep = (size_t)(BK * 2);
    const size_t hstep = (size_t)HALF * K * 2;
    const size_t tstep = 2 * hstep;
    const unsigned ldsw = (unsigned)wid * 1024u;
    const int aoff = lds_byte(wr * 64 + fr, fq * 8), boff = lds_byte(wc * 32 + fr, fq * 8);
#define PG8_SA(b, h) (((b) * 2 + (h)) * HTB)
#define PG8_SB(b, h) ((4 + (b) * 2 + (h)) * HTB)
#define PG8_STAGE(bufoff, gbase, voff) do { _Pragma("unroll") for (int _i = 0; _i < 2; ++_i) \
        __builtin_amdgcn_global_load_lds((const unsigned*)((const char*)(gbase) + (voff)[_i]), (PG8_LAS unsigned*)(lds + (bufoff) + ldsw + _i * 8192), 16, 0, 0); } while (0)
#define PG8_LDA(dst, b, h) do { _Pragma("unroll") for (int m = 0; m < 4; ++m) _Pragma("unroll") for (int k = 0; k < 2; ++k) dst[m][k] = *(const PG8_LAS bf16x8*)(lds + PG8_SA(b, h) + aoff + m * 2048 + k * 1024); } while (0)
#define PG8_LDB(dst, b, h) do { _Pragma("unroll") for (int n = 0; n < 2; ++n) _Pragma("unroll") for (int k = 0; k < 2; ++k) dst[n][k] = *(const PG8_LAS bf16x8*)(lds + PG8_SB(b, h) + boff + n * 2048 + k * 1024); } while (0)
#define PG8_MMA(ai, bj, At, Bt) do { __builtin_amdgcn_s_setprio(1); _Pragma("unroll") for (int m = 0; m < 4; ++m) _Pragma("unroll") for (int n = 0; n < 2; ++n) _Pragma("unroll") for (int k = 0; k < 2; ++k) \
        acc[ai][bj][m][n] = __builtin_amdgcn_mfma_f32_16x16x32_bf16(Bt[n][k], At[m][k], acc[ai][bj][m][n], 0, 0, 0); __builtin_amdgcn_s_setprio(0); } while (0)
#define PG8_WAIT_V(n) asm volatile("s_waitcnt vmcnt(" #n ")" ::: "memory")
#define PG8_WAIT_L(n) asm volatile("s_waitcnt lgkmcnt(" #n ")" ::: "memory")
#define PG8_BAR __builtin_amdgcn_s_barrier()
#define PG8_SCHED __builtin_amdgcn_sched_barrier(0)
    Unit cur, nxt; int ui = 0;
    if (!S.next(0, cur)) return;
    f32x4 acc[2][2][4][2];
#pragma unroll
    for (int a = 0; a < 2; ++a)
#pragma unroll
        for (int b = 0; b < 2; ++b)
#pragma unroll
            for (int m = 0; m < 4; ++m)
#pragma unroll
                for (int n = 0; n < 2; ++n) acc[a][b][m][n] = (f32x4){0.f, 0.f, 0.f, 0.f};
    bf16x8 At[4][2], B0[2][2], B1[2][2];
    const char* cA = (const char*)g.A + (size_t)cur.pm * tstep; const char* cB = (const char*)g.Bt + (size_t)cur.pn * tstep;
    S.a_ready(cur);
    if constexpr (Epi::RSTD_LDS) { if (wid < 4) __builtin_amdgcn_global_load_lds((const unsigned*)(E.rstd + cur.pm * BM + wid * 64 + lane), (PG8_LAS unsigned*)(lds + STAGE_BYTES + wid * 256), 4, 0, 0); }
    if constexpr (SP2) {
        PG8_STAGE(PG8_SB(0, 0), cB, voffB); PG8_STAGE(PG8_SB(0, 1), cB + hstep, voffB); PG8_STAGE(PG8_SA(0, 0), cA, voffA); PG8_STAGE(PG8_SA(0, 1), cA + hstep, voffA);
        if (wr == 1) PG8_BAR;
        PG8_WAIT_V(2); PG8_BAR;
        PG8_STAGE(PG8_SB(1, 0), cB + kstep, voffB); PG8_STAGE(PG8_SA(1, 0), cA + kstep, voffA); PG8_STAGE(PG8_SB(1, 1), cB + hstep + kstep, voffB);
        PG8_WAIT_V(6); PG8_BAR;
    } else {
        PG8_STAGE(PG8_SB(0, 0), cB, voffB); PG8_STAGE(PG8_SA(0, 0), cA, voffA); PG8_STAGE(PG8_SB(0, 1), cB + hstep, voffB); PG8_STAGE(PG8_SA(0, 1), cA + hstep, voffA);
        if (wr == 1) PG8_BAR;
        PG8_WAIT_V(4); PG8_BAR;
        PG8_STAGE(PG8_SB(1, 0), cB + kstep, voffB); PG8_STAGE(PG8_SA(1, 0), cA + kstep, voffA); PG8_STAGE(PG8_SB(1, 1), cB + hstep + kstep, voffB);
        PG8_WAIT_V(6); PG8_BAR;
    }
    for (;;) {
        const bool has_next = S.next(ui + 1, nxt);
        const char* nA = has_next ? (const char*)g.A + (size_t)nxt.pm * tstep : cA; const char* nB = has_next ? (const char*)g.Bt + (size_t)nxt.pn * tstep : cB;
        for (int t = 0; t < nt; t += 2) {
            const bool last = (t == nt - 2);
            const char* a1 = cA + (size_t)(t + 1) * kstep;
            const char* a2 = last ? nA : cA + (size_t)(t + 2) * kstep; const char* b2 = last ? nB : cB + (size_t)(t + 2) * kstep;
            const char* a3 = a2 + kstep; const char* b3 = b2 + kstep;
            if (last && has_next) S.a_ready(nxt);
            if constexpr (Epi::RSTD_LDS) { if (last && has_next && wid < 4) __builtin_amdgcn_global_load_lds((const unsigned*)(E.rstd + nxt.pm * BM + wid * 64 + lane), (PG8_LAS unsigned*)(lds + STAGE_BYTES + ((ui + 1) & 1) * 1024 + wid * 256), 4, 0, 0); }
            if constexpr (SP2) {
            PG8_LDB(B0, 0, 0); PG8_LDB(B1, 0, 1); PG8_SCHED; PG8_LDA(At, 0, 0); PG8_STAGE(PG8_SA(1, 1), a1 + hstep, voffA);
            PG8_WAIT_V(8); PG8_WAIT_L(0); PG8_BAR; PG8_MMA(0, 0, At, B0); PG8_MMA(0, 1, At, B1); PG8_BAR; PG8_SCHED;
            PG8_LDA(At, 0, 1); PG8_STAGE(PG8_SB(0, 0), b2, voffB); PG8_STAGE(PG8_SB(0, 1), b2 + hstep, voffB); PG8_STAGE(PG8_SA(0, 0), a2, voffA);
            PG8_WAIT_V(8); PG8_WAIT_L(0); PG8_BAR; PG8_MMA(1, 0, At, B0); PG8_MMA(1, 1, At, B1); PG8_BAR; PG8_SCHED;
            PG8_LDB(B0, 1, 0); PG8_LDB(B1, 1, 1); PG8_SCHED; PG8_LDA(At, 1, 0); PG8_STAGE(PG8_SA(0, 1), a2 + hstep, voffA);
            PG8_WAIT_V(8); PG8_WAIT_L(0); PG8_BAR; PG8_MMA(0, 0, At, B0); PG8_MMA(0, 1, At, B1); PG8_BAR; PG8_SCHED;
            PG8_LDA(At, 1, 1); PG8_STAGE(PG8_SB(1, 0), b3, voffB); PG8_STAGE(PG8_SB(1, 1), b3 + hstep, voffB); PG8_STAGE(PG8_SA(1, 0), a3, voffA);
            PG8_WAIT_V(8); PG8_WAIT_L(0); PG8_BAR; PG8_MMA(1, 0, At, B0); PG8_MMA(1, 1, At, B1); PG8_BAR; PG8_SCHED;
            } else {
            PG8_LDB(B0, 0, 0); PG8_SCHED; PG8_LDA(At, 0, 0); PG8_STAGE(PG8_SA(1, 1), a1 + hstep, voffA);
            PG8_WAIT_L(8); PG8_BAR; PG8_WAIT_L(0); PG8_MMA(0, 0, At, B0); PG8_BAR; PG8_SCHED;
            PG8_LDB(B1, 0, 1); PG8_STAGE(PG8_SB(0, 0), b2, voffB);
            PG8_BAR; PG8_WAIT_L(0); PG8_MMA(0, 1, At, B1); PG8_BAR;
            PG8_LDA(At, 0, 1); PG8_STAGE(PG8_SA(0, 0), a2, voffA);
            PG8_BAR; PG8_WAIT_L(0); PG8_MMA(1, 0, At, B0); PG8_BAR; PG8_SCHED;
            PG8_STAGE(PG8_SB(0, 1), b2 + hstep, voffB);
            PG8_WAIT_V(6); PG8_BAR; PG8_MMA(1, 1, At, B1); PG8_BAR;
            PG8_LDB(B0, 1, 0); PG8_SCHED; PG8_LDA(At, 1, 0); PG8_STAGE(PG8_SA(0, 1), a2 + hstep, voffA);
            PG8_WAIT_L(8); PG8_BAR; PG8_WAIT_L(0); PG8_MMA(0, 0, At, B0); PG8_BAR; PG8_SCHED;
            PG8_LDB(B1, 1, 1); PG8_STAGE(PG8_SB(1, 0), b3, voffB);
            PG8_BAR; PG8_WAIT_L(0); PG8_MMA(0, 1, At, B1); PG8_BAR;
            PG8_LDA(At, 1, 1); PG8_STAGE(PG8_SA(1, 0), a3, voffA);
            PG8_BAR; PG8_WAIT_L(0); PG8_MMA(1, 0, At, B0); PG8_BAR; PG8_SCHED;
            PG8_STAGE(PG8_SB(1, 1), b3 + hstep, voffB);
            PG8_WAIT_V(6); PG8_BAR; PG8_MMA(1, 1, At, B1); PG8_BAR;
            }
        }
        if constexpr (ALIGN_EPI) { if (wr == 0) PG8_BAR; }
        if constexpr (!Epi::AFTER_DRAIN) { if constexpr (Epi::RSTD_LDS) E(acc, cur, wr, wc, fr, fq, (const PG8_LAS float*)(lds + STAGE_BYTES + (ui & 1) * 1024)); else E(acc, cur, wr, wc, fr, fq); S.done(cur); }
        if (!has_next) break;
#pragma unroll
        for (int a = 0; a < 2; ++a)
#pragma unroll
            for (int b = 0; b < 2; ++b)
#pragma unroll
                for (int m = 0; m < 4; ++m)
#pragma unroll
                    for (int n = 0; n < 2; ++n) acc[a][b][m][n] = (f32x4){0.f, 0.f, 0.f, 0.f};
        cur = nxt; cA = nA; cB = nB; ++ui;
        if constexpr (ALIGN_EPI) { if (wr == 1) PG8_BAR; }
    }
    PG8_WAIT_V(0);
    if constexpr (!ALIGN_EPI) { if (wr == 0) PG8_BAR; }
    PG8_BAR;
    if constexpr (Epi::AFTER_DRAIN) { E.fused(acc, cur, wr, wc, fr, fq, lds, wid, lane); S.done(cur); }
#undef PG8_SA
#undef PG8_SB
#undef PG8_STAGE
#undef PG8_LDA
#undef PG8_LDB
#undef PG8_MMA
#undef PG8_WAIT_V
#undef PG8_WAIT_L
#undef PG8_BAR
#undef PG8_SCHED
}
}

namespace att {
#define ALAS __attribute__((address_space(3)))
constexpr int D = 128, RS = 1024;
constexpr float SCALE = 0.08838834764831845f;
constexpr float THR = 8.f;
constexpr bool WSKIP = false;
constexpr int NW = 8, QBLK = 32, KVBLK = 64, QB = NW * QBLK;
constexpr int SHM_V = KVBLK * D * 2, SHM_K = KVBLK * D * 2;
constexpr int LDS_CORE = 2 * SHM_V + 2 * SHM_K + NW * 64 * 4;
constexpr int KB_OFF = LDS_CORE;
constexpr int LDS_BYTES = KB_OFF + 8192 * 4;
using bf16 = __hip_bfloat16;
typedef short bf16x8 __attribute__((ext_vector_type(8)));
typedef short s16x4 __attribute__((ext_vector_type(4)));
typedef float f32x16 __attribute__((ext_vector_type(16)));
typedef float f32x4 __attribute__((ext_vector_type(4)));
typedef unsigned u32x4 __attribute__((ext_vector_type(4)));
template <class A, class Bt> struct same_t { static constexpr bool v = false; };
template <class A> struct same_t<A, A> { static constexpr bool v = true; };

#define KSWZ(row, colB) ((row) * 256 + ((colB) ^ (((row) & 7) << 4)))
#define SBAR() __builtin_amdgcn_sched_barrier(0)
__device__ __forceinline__ int v_st(int k, int c) { const int kk = (k & ~0xC) | ((k & 4) << 1) | ((k & 8) >> 1); return ((kk >> 3) * 4 + (c >> 5)) * 512 + ((kk & 7) * 32 + (c & 31)) * 2; }
__device__ __forceinline__ int v_rd_base(int lane) { return ((lane & 3) << 3) | (((lane >> 2) & 3) << 6) | (((lane >> 4) & 1) << 5) | (((lane >> 5) & 1) << 8); }
constexpr int v_rd_off(int d0, int ks, int half) { return d0 * 512 + ks * 4096 + half * 2048; }
__device__ __forceinline__ int crow(int r, int hi) { return (r & 3) + 8 * (r >> 2) + 4 * hi; }
__device__ __forceinline__ unsigned cvtpk(float lo, float hi) {
    typedef float f32x2_t __attribute__((ext_vector_type(2))); typedef __bf16 bf16x2_t __attribute__((ext_vector_type(2)));
    f32x2_t v = {lo, hi}; bf16x2_t b = __builtin_convertvector(v, bf16x2_t); return __builtin_bit_cast(unsigned, b);
}
__device__ __forceinline__ bf16x8 pack8(f32x4 a, f32x4 b) {
    u32x4 w = {cvtpk(a[0], a[1]), cvtpk(a[2], a[3]), cvtpk(b[0], b[1]), cvtpk(b[2], b[3])};
    return *reinterpret_cast<bf16x8*>(&w);
}
template <class T> __device__ __forceinline__ bf16x8 load8(const T* p) {
    if constexpr (same_t<T, float>::v) { return pack8(*(const f32x4*)p, *(const f32x4*)(p + 4)); }
    else { return *reinterpret_cast<const bf16x8*>(p); }
}
__device__ __forceinline__ void mask_tile(f32x16& p0, f32x16& p1, int dq, unsigned W) {
    const float NEG = -__builtin_inff();
#pragma unroll
    for (int r = 0; r < 16; ++r) {
        const int c = (r & 3) + 8 * (r >> 2);
        if ((unsigned)(dq - c) >= W) p0[r] = NEG;
        if ((unsigned)(dq - c - 32) >= W) p1[r] = NEG;
    }
}
__device__ __forceinline__ void partialSM(f32x16& p0, f32x16& p1, float& m_reg, float& mn, float& alpha) {
    float pmax = p0[0]; for (int r = 1; r < 16; ++r) pmax = fmaxf(pmax, p0[r]); for (int r = 0; r < 16; ++r) pmax = fmaxf(pmax, p1[r]);
    { auto rr = __builtin_amdgcn_permlane32_swap(__float_as_uint(pmax), __float_as_uint(pmax), false, false);
      pmax = fmaxf(__uint_as_float(rr[0]), __uint_as_float(rr[1])); }
    constexpr float C2 = 1.4426950408889634f * SCALE;
    if (__builtin_expect(__all((pmax - m_reg) * SCALE <= THR), 1)) { mn = m_reg; alpha = 1.f; }
    else { mn = fmaxf(m_reg, pmax); alpha = __builtin_amdgcn_exp2f((m_reg - mn) * C2); m_reg = mn; }
    const float mnL = -mn * C2;
    for (int r = 0; r < 16; ++r) p0[r] = fmaf(p0[r], C2, mnL); for (int r = 0; r < 16; ++r) p1[r] = fmaf(p1[r], C2, mnL);
    for (int r = 0; r < 16; ++r) p0[r] = __builtin_amdgcn_exp2f(p0[r]);
}
__device__ __forceinline__ void finishSM(f32x16& p0, f32x16& p1, float alpha, float& l_reg, bf16x8& pa0, bf16x8& pa1, bf16x8& pa2, bf16x8& pa3) {
    for (int r = 0; r < 16; ++r) p1[r] = __builtin_amdgcn_exp2f(p1[r]);
    float ps = 0; for (int r = 0; r < 16; ++r) ps += p0[r]; for (int r = 0; r < 16; ++r) ps += p1[r];
    { auto rr = __builtin_amdgcn_permlane32_swap(__float_as_uint(ps), __float_as_uint(ps), false, false);
      ps = __uint_as_float(rr[0]) + __uint_as_float(rr[1]); }
    l_reg = l_reg * alpha + ps;
#define PK4(P, B_, OUT) do { unsigned a0 = cvtpk(P[B_+0], P[B_+1]), a1 = cvtpk(P[B_+2], P[B_+3]);                          \
        unsigned b0 = cvtpk(P[B_+4], P[B_+5]), b1 = cvtpk(P[B_+6], P[B_+7]);                                             \
        auto r0 = __builtin_amdgcn_permlane32_swap(a0, b0, false, false); auto r1 = __builtin_amdgcn_permlane32_swap(a1, b1, false, false); \
        u32x4 w = {r0[0], r1[0], r0[1], r1[1]}; OUT = *reinterpret_cast<bf16x8*>(&w); } while (0)
    PK4(p0, 0, pa0); PK4(p0, 8, pa1); PK4(p1, 0, pa2); PK4(p1, 8, pa3);
#undef PK4
}
template <int KB>
__device__ __forceinline__ void qkt(f32x16& p0, f32x16& p1, const char* K_lds, int r32, int hi, const bf16x8* qr, const ALAS float* kbt) {
#pragma unroll
    for (int g = 0; g < 4; ++g) { const f32x4 a = *(const ALAS f32x4*)(kbt + 8 * g), b = *(const ALAS f32x4*)(kbt + 32 + 8 * g);
        p0[4 * g] = a[0]; p0[4 * g + 1] = a[1]; p0[4 * g + 2] = a[2]; p0[4 * g + 3] = a[3];
        p1[4 * g] = b[0]; p1[4 * g + 1] = b[1]; p1[4 * g + 2] = b[2]; p1[4 * g + 3] = b[3]; }
    const char* kb[4];
#pragma unroll
    for (int dd = 0; dd < 4; ++dd) kb[dd] = K_lds + KB * SHM_K + KSWZ(r32, (dd * 16 + hi * 8) * 2);
#pragma unroll
    for (int d0 = 0; d0 < 8; ++d0) { const char* a = kb[d0 & 3] + (d0 >> 2) * 128;
        bf16x8 b0 = *reinterpret_cast<const bf16x8*>(a);
        bf16x8 b1 = *reinterpret_cast<const bf16x8*>(a + 32 * 256);
        p0 = __builtin_amdgcn_mfma_f32_32x32x16_bf16(b0, qr[d0], p0, 0, 0, 0);
        p1 = __builtin_amdgcn_mfma_f32_32x32x16_bf16(b1, qr[d0], p1, 0, 0, 0); }
}
template <int VB, bool SK>
__device__ __forceinline__ void pv_tile(f32x16* o, int vb0, bf16x8 pa0, bf16x8 pa1, bf16x8 pa2, bf16x8 pa3, bool act) {
    if (SK && !act) return;
#define TRRD(dst, off) asm volatile("ds_read_b64_tr_b16 %0, %1 offset:%2" : "=&v"(dst) : "v"(vb0), "i"(off) : "memory")
#define PV_D0(d0) do { s16x4 l0, l1, l2, l3, h0, h1, h2, h3; constexpr int b_ = VB * SHM_V + v_rd_off(d0, 0, 0);     \
        TRRD(l0, b_); TRRD(h0, b_ + 2048); TRRD(l1, b_ + 4096); TRRD(h1, b_ + 6144); TRRD(l2, b_ + 8192); TRRD(h2, b_ + 10240); TRRD(l3, b_ + 12288); TRRD(h3, b_ + 14336); \
        asm volatile("s_waitcnt lgkmcnt(0)" ::: "memory"); SBAR();                 \
        o[d0] = __builtin_amdgcn_mfma_f32_32x32x16_bf16(pa0, (bf16x8){l0[0], l0[1], l0[2], l0[3], h0[0], h0[1], h0[2], h0[3]}, o[d0], 0, 0, 0);   \
        o[d0] = __builtin_amdgcn_mfma_f32_32x32x16_bf16(pa1, (bf16x8){l1[0], l1[1], l1[2], l1[3], h1[0], h1[1], h1[2], h1[3]}, o[d0], 0, 0, 0);   \
        o[d0] = __builtin_amdgcn_mfma_f32_32x32x16_bf16(pa2, (bf16x8){l2[0], l2[1], l2[2], l2[3], h2[0], h2[1], h2[2], h2[3]}, o[d0], 0, 0, 0);   \
        o[d0] = __builtin_amdgcn_mfma_f32_32x32x16_bf16(pa3, (bf16x8){l3[0], l3[1], l3[2], l3[3], h3[0], h3[1], h3[2], h3[3]}, o[d0], 0, 0, 0); } while (0)
    PV_D0(0); PV_D0(1); PV_D0(2); PV_D0(3);
#undef PV_D0
#undef TRRD
}

struct BlockRef { const bf16* Q; const bf16* K; const bf16* V; bf16* O; const bf16* GA; const bf16* OB; int P0; int jlo; int bh; };
struct Seam { bf16x8 qr[8]; bf16x8 st_v0, st_v1, st_k0, st_k1; };
#define VMW() asm volatile("s_waitcnt vmcnt(0)" ::: "memory")
#define VMWN(n) asm volatile("s_waitcnt vmcnt(%0)" :: "i"(n) : "memory")
#define SLOAD_H(Kp, Vp, k0) do { const bf16* kt_ = (Kp) + (size_t)(k0) * RS; const bf16* vt_ = (Vp) + (size_t)(k0) * RS;                      \
                         S.st_v0 = load8<bf16>(vt_ + kvo0); S.st_v1 = load8<bf16>(vt_ + kvo1);                                       \
                         S.st_k0 = load8<bf16>(kt_ + kvo0); S.st_k1 = load8<bf16>(kt_ + kvo1); } while (0)
#define SWRITE_HK(bf) do { *(bf16x8*)(K_lds + (bf) * SHM_K + kws) = S.st_k0; *(bf16x8*)(K_lds + (bf) * SHM_K + kws + 32 * 256) = S.st_k1; } while (0)
#define SWRITE_HV(bf) do { *(bf16x8*)(V_lds + (bf) * SHM_V + vst0) = S.st_v0; *(bf16x8*)(V_lds + (bf) * SHM_V + vst1) = S.st_v1; } while (0)
#define SWRITE_H(bf) do { SWRITE_HV(bf); SWRITE_HK(bf); } while (0)
__device__ __forceinline__ void fox_prime(const BlockRef& cur, char* lds, Seam& S, int wave_s) {
    int tid = 0; asm volatile("" : "+v"(tid)); tid = wave_s * 64 + (int)__builtin_amdgcn_mbcnt_hi(~0u, __builtin_amdgcn_mbcnt_lo(~0u, (unsigned)tid)); asm volatile("" : "+v"(tid));
    const int wid = __builtin_amdgcn_readfirstlane(tid >> 6), lane = tid & 63, r32 = lane & 31, hi = lane >> 5;
    const int sr = tid >> 4, sc = (tid & 15) * 8, kws = KSWZ(sr, sc * 2); char* K_lds = lds + 2 * SHM_V;
    const unsigned kvo0 = (unsigned)(sr * RS + sc), kvo1 = kvo0 + 32u * RS, qo = (unsigned)(r32 * RS + hi * 8);
    { const bf16* qb_ = cur.Q + (size_t)(wid * QBLK) * RS;
#pragma unroll
    for (int d0 = 0; d0 < 8; ++d0) S.qr[d0] = load8<bf16>(qb_ + qo + d0 * 16); }
    SLOAD_H(cur.K, cur.V, cur.jlo * KVBLK); VMW(); SWRITE_HK(0);
    __syncthreads();
}
constexpr int CW_QCTR = 3584, CW_NRM = 3616;
constexpr float FOX_L = 32.0f;
struct FoxCtx { unsigned short* Qb; const unsigned short* Kb; const unsigned short* Vb; const unsigned short* GAb; const unsigned short* OBb; const float* kbias; unsigned* ctl; volatile ALAS unsigned* slot; };
__device__ __forceinline__ BlockRef fox_mkref(int n, const FoxCtx& cx, int lane) {
    unsigned short* Qb = cx.Qb; const unsigned short* Kb = cx.Kb; const unsigned short* Vb = cx.Vb; const unsigned short* GAb = cx.GAb; const unsigned short* OBb = cx.OBb; const float* kbias = cx.kbias; const unsigned* ctl = cx.ctl;
    const int bh = n & 31, qb = 31 - (n >> 5), b = bh >> 3, h = bh & 7;
    const size_t qo = ((size_t)b * 8192 + (size_t)qb * 256) * RS + h * 128, ko = (size_t)b * 8192 * RS + h * 128;
    BlockRef r; r.Q = (const bf16*)(Qb + qo); r.O = (bf16*)(Qb + qo); r.K = (const bf16*)(Kb + ko); r.V = (const bf16*)(Vb + ko);
    r.GA = (const bf16*)(GAb + qo); r.OB = (const bf16*)(OBb + qo); r.P0 = qb * 256; r.bh = bh;
    const float* kbg = kbias + (size_t)bh * 8192; const int nt0 = r.P0 >> 6;
    const float kb0 = kbg[r.P0], ka = kbg[64 * lane + 63], kb_ = kbg[64 * (lane + 64) + 63];
    f32x4 qv_, kv_;
    { const unsigned* np_ = ctl + CW_NRM + bh * 8;
      asm volatile("global_load_dwordx4 %0, %2, off sc0 sc1\n\tglobal_load_dwordx4 %1, %2, off offset:16 sc0 sc1\n\ts_waitcnt vmcnt(0)" : "=&v"(qv_), "=&v"(kv_) : "v"(np_) : "memory"); }
    const float qn2 = (qv_.x + qv_.y) + (qv_.z + qv_.w), kn2 = (kv_.x + kv_.y) + (kv_.z + kv_.w);
    const float thr = FOX_L * 11.313708498984761f + 2.05f * sqrtf(qn2 * kn2);
    const int cnt = __popcll(__ballot(lane < nt0 && (kb0 - ka) > thr)) + __popcll(__ballot(lane + 64 < nt0 && (kb0 - kb_) > thr));
    r.jlo = __builtin_amdgcn_readfirstlane(cnt);
    return r;
}
__device__ __forceinline__ unsigned fox_fetch(unsigned* ctl) { return __hip_atomic_fetch_add(ctl + CW_QCTR, 1u, __ATOMIC_RELAXED, __HIP_MEMORY_SCOPE_AGENT); }
__device__ __forceinline__ void fox_block(const BlockRef& cur, BlockRef& nxt, bool& last, const FoxCtx& cx, char* lds, const ALAS float* kbl, Seam& S, int wave_s) {
    int tid = 0; asm volatile("" : "+v"(tid)); tid = wave_s * 64 + (int)__builtin_amdgcn_mbcnt_hi(~0u, __builtin_amdgcn_mbcnt_lo(~0u, (unsigned)tid)); asm volatile("" : "+v"(tid));
    const int wid = __builtin_amdgcn_readfirstlane(tid >> 6), lane = tid & 63, r32 = lane & 31, hi = lane >> 5;
    constexpr int W = 1 << 30; constexpr bool SK = false;
    const int j_lo = cur.jlo, NT = (cur.P0 + QB - 1) / KVBLK + 1 - j_lo;
    const int qlo = cur.P0 + wid * QBLK, qm = qlo + r32 - 4 * hi;
    char* V_lds = lds; char* K_lds = lds + 2 * SHM_V;
    float* ws = (float*)(lds + 2 * SHM_V + 2 * SHM_K) + wid * 64; float* li_l = ws, * al_l = ws + 32;
    float m_reg = -1e30f, l_reg = 0; f32x16 o[4] = {};
    const int sr = tid >> 4, sc = (tid & 15) * 8, vst0 = v_st(sr, sc), vst1 = v_st(32 + sr, sc), kws = KSWZ(sr, sc * 2);
    const int vb0 = (int)(uintptr_t)V_lds + v_rd_base(lane);
    const unsigned kvo0 = (unsigned)(sr * RS + sc), kvo1 = kvo0 + 32u * RS, qo = (unsigned)(r32 * RS + hi * 8);
    const bf16* Kh = cur.K; const bf16* Vh = cur.V;
    const ALAS float* kbh = kbl + 4 * hi;
#define RESC(a) do { if (__any((a) < 1.f)) { if (hi == 0) al_l[r32] = (a); asm volatile("s_waitcnt lgkmcnt(0)" ::: "memory");              \
                     for (int d_ = 0; d_ < 4; ++d_) for (int r = 0; r < 16; ++r) o[d_][r] *= al_l[crow(r, hi)]; } } while (0)
#define KBASE(t) ((j_lo + (t)) * KVBLK)
#define MASKT(P0_, P1_, t) do { const int kb_ = KBASE(t); if (kb_ + KVBLK - 1 > qlo) mask_tile(P0_, P1_, qm - kb_, (unsigned)W); } while (0)
    constexpr int NQL = 8;
#define SEAM_K0() do { VMWN(NQL); SWRITE_HK(0); SBAR(); } while (0)
    f32x16 pA0, pA1, pB0, pB1; float mnA, mnB, alA, alB; bf16x8 pa0, pa1, pa2, pa3;
    SWRITE_HV(0); SBAR();
    if (NT > 1) { SLOAD_H(Kh, Vh, KBASE(1)); }
    SBAR(); qkt<0>(pA0, pA1, K_lds, r32, hi, S.qr, kbh + KBASE(0));
    MASKT(pA0, pA1, 0); partialSM(pA0, pA1, m_reg, mnA, alA);
    if (NT > 1) { VMW(); SWRITE_H(1); }
    __syncthreads();
#define HALF_STEP(PX0, PX1, mnX, alX, PY0, PY1, alY, t, KB, VB, SB) do {                                                      \
        SBAR(); qkt<KB>(PX0, PX1, K_lds, r32, hi, S.qr, kbh + KBASE(t));                                                      \
        finishSM(PY0, PY1, alY, l_reg, pa0, pa1, pa2, pa3); SBAR();                                                           \
        if ((t) + 1 < NT) { SLOAD_H(Kh, Vh, KBASE((t) + 1)); SBAR(); }                                                        \
        pv_tile<VB, SK>(o, vb0, pa0, pa1, pa2, pa3, true); MASKT(PX0, PX1, (t)); partialSM(PX0, PX1, m_reg, mnX, alX);         \
        __syncthreads();                                                                                                      \
        if ((t) + 1 < NT) { VMW(); SWRITE_H(SB); }                                                                            \
        RESC(alX); __syncthreads(); } while (0)
    const int tf = NT >= 8 ? ((NT - 5) | 1) : -1;
    if (tf < 0 && tid == 0) cx.slot[0] = fox_fetch(cx.ctl);
    for (int t = 1; t + 1 < NT; t += 2) {
        if (t == tf && tid == 0) cx.slot[0] = fox_fetch(cx.ctl);
        HALF_STEP(pB0, pB1, mnB, alB, pA0, pA1, alA, t, 1, 0, 0);
        HALF_STEP(pA0, pA1, mnA, alA, pB0, pB1, alB, t + 1, 0, 1, 1);
    }
    const bool even = (NT & 1) == 0;
    if (even) { SBAR(); qkt<1>(pB0, pB1, K_lds, r32, hi, S.qr, kbh + KBASE(NT - 1)); SBAR(); }
    { const int n_nxt = __builtin_amdgcn_readfirstlane((int)cx.slot[0]);
      last = n_nxt >= 1024; if (last) nxt = cur; else nxt = fox_mkref(n_nxt, cx, lane); }
    SBAR();
    SLOAD_H(nxt.K, nxt.V, nxt.jlo * KVBLK); SBAR();
    { const bf16* qb_ = nxt.Q + (size_t)(wid * QBLK) * RS;
#pragma unroll
    for (int d0 = 0; d0 < 8; ++d0) S.qr[d0] = load8<bf16>(qb_ + qo + d0 * 16); }
    SBAR();
    finishSM(pA0, pA1, alA, l_reg, pa0, pa1, pa2, pa3); SBAR();
    pv_tile<0, SK>(o, vb0, pa0, pa1, pa2, pa3, true);
    if (even) { MASKT(pB0, pB1, NT - 1); partialSM(pB0, pB1, m_reg, mnB, alB); __syncthreads(); RESC(alB);
        finishSM(pB0, pB1, alB, l_reg, pa0, pa1, pa2, pa3); SBAR(); pv_tile<1, SK>(o, vb0, pa0, pa1, pa2, pa3, true); }
    SBAR(); SEAM_K0();
    if (hi == 0) li_l[r32] = l_reg; asm volatile("s_waitcnt lgkmcnt(0)" ::: "memory");
    float rli[16];
#pragma unroll
    for (int r = 0; r < 16; ++r) rli[r] = __builtin_amdgcn_rcpf(li_l[crow(r, hi)]);
    const size_t wofs = (size_t)(wid * QBLK) * RS; const bf16* gab = cur.GA + wofs; const bf16* obb = cur.OB + wofs; bf16* oub = cur.O + wofs;
    const unsigned eo = (unsigned)(hi * 4 * RS + r32);
    unsigned gav[2][2][4], obv[2][2][4];
#define EPI_LOAD(rg_) do { _Pragma("unroll") for (int rr = 0; rr < 2; ++rr) _Pragma("unroll") for (int d0 = 0; d0 < 4; ++d0) { const int r = (rg_) * 2 + rr, co = ((r & 3) + 8 * (r >> 2)) * RS + d0 * 32; \
        gav[(rg_) & 1][rr][d0] = ((const unsigned short*)(gab + co))[eo]; obv[(rg_) & 1][rr][d0] = ((const unsigned short*)(obb + co))[eo]; } } while (0)
    EPI_LOAD(0);
#pragma unroll
    for (int rg = 0; rg < 8; ++rg) {
        if (rg < 7) EPI_LOAD(rg + 1);
        SBAR();
#pragma unroll
        for (int rr = 0; rr < 2; ++rr)
#pragma unroll
            for (int d0 = 0; d0 < 4; ++d0) { const int r = rg * 2 + rr, co = ((r & 3) + 8 * (r >> 2)) * RS + d0 * 32;
                const float v = o[d0][r] * rli[r];
                const float m = __uint_as_float(gav[rg & 1][rr][d0] << 16) * v + __uint_as_float(obv[rg & 1][rr][d0] << 16);
                ((unsigned short*)(oub + co))[eo] = (unsigned short)(cvtpk(m, 0.f) & 0xffffu); }
        SBAR(); }
#undef EPI_LOAD
    __syncthreads();
#undef RESC
#undef KBASE
#undef MASKT
#undef SEAM_K0
#undef HALF_STEP
}
#undef ROW
#undef VMW
#undef VMWN
#undef SLOAD_H
#undef SWRITE_HK
#undef SWRITE_HV
#undef SWRITE_H
#undef SBAR
#undef KSWZ
}

#define LAS __attribute__((address_space(3)))
typedef unsigned short bf16u;
typedef unsigned v4u __attribute__((ext_vector_type(4)));
typedef float v4f __attribute__((ext_vector_type(4)));
typedef short v8s __attribute__((ext_vector_type(8)));
typedef float v16f __attribute__((ext_vector_type(16)));

constexpr int T = 32768, DM = 1024, FF = 4096, SEQ = 8192, NH = 8, INW = 7176;
constexpr float RMS_EPS = 1e-6f, LN_EPS = 1e-5f;
constexpr size_t MiB = 1u << 20;
constexpr size_t WS_RSTD0 = 0, WS_RSTD1 = 128 * 1024, WS_RSTD2 = 256 * 1024, WS_WF = 384 * 1024, WS_WSM = 512 * 1024, WS_LOGF = 1 * MiB, WS_KBIAS = 2 * MiB, WS_BAR = 3 * MiB, BAR_BYTES = 16384;
constexpr size_t WS_WGU1 = 4 * MiB, WS_WD1 = 20 * MiB, WS_WIN = 28 * MiB, WS_WOUT = 42 * MiB, WS_WGU2 = 44 * MiB, WS_WD2 = 60 * MiB;
constexpr size_t WS_R0 = 68 * MiB, WS_S0 = 132 * MiB, WS_S1 = 196 * MiB, WS_S2 = 260 * MiB, WS_S3 = 324 * MiB, WS_S4 = 388 * MiB, WS_END = 452 * MiB;
constexpr int LDS_TOTAL = 140 * 1024, LDS_MISC = 136 * 1024;

__device__ __forceinline__ unsigned f2bf(float f) { unsigned u = __builtin_bit_cast(unsigned, f); return (u + 0x7fffu + ((u >> 16) & 1u)) >> 16; }
__device__ __forceinline__ unsigned pk2(float lo, float hi) { return f2bf(lo) | (f2bf(hi) << 16); }
__device__ __forceinline__ float bflo(unsigned w) { return __uint_as_float(w << 16); }
__device__ __forceinline__ float bfhi(unsigned w) { return __uint_as_float(w & 0xffff0000u); }
template <int X> __device__ __forceinline__ float swz_xor(float v) { return __int_as_float(__builtin_amdgcn_ds_swizzle(__float_as_int(v), (X << 10) | 0x1f)); }
template <int CTRL> __device__ __forceinline__ float dpp_f(float v) { return __int_as_float(__builtin_amdgcn_update_dpp(0, __float_as_int(v), CTRL, 0xf, 0xf, false)); }
__device__ __forceinline__ float wave_sum(float v) {
    v += dpp_f<0xB1>(v); v += dpp_f<0x4E>(v); v += dpp_f<0x141>(v); v += dpp_f<0x140>(v); v += swz_xor<16>(v);
    auto rr = __builtin_amdgcn_permlane32_swap(__float_as_uint(v), __float_as_uint(v), false, false);
    return __uint_as_float(rr[0]) + __uint_as_float(rr[1]);
}

#define CAS __attribute__((address_space(4)))
#define XB_TMO      128
#define XB_XCNT(j)  (256  + 64 * (j))
#define XB_XSUB(j)  (1280 + 64 * (j))
#define XB_XGEN(j)  (2304 + 64 * (j))
#define XB_TOP      3328
#define XB_TOPGEN   3392
#define XCD_BAR_WORDS 3456
#define XB_SPIN_CAP (1u << 18)

__device__ __forceinline__ unsigned xb_ld(unsigned* p)              { return __hip_atomic_load(p, __ATOMIC_RELAXED, __HIP_MEMORY_SCOPE_AGENT); }
__device__ __forceinline__ unsigned xb_add(unsigned* p, unsigned v) { return __hip_atomic_fetch_add(p, v, __ATOMIC_RELAXED, __HIP_MEMORY_SCOPE_AGENT); }
__device__ __forceinline__ unsigned xb_xcc_id() { return (unsigned)__builtin_amdgcn_s_getreg((3 << 11) | 20) & 0xFu; }
#define XB_SPIN(cond, bar) do { unsigned _sp = 0; while (cond) { __builtin_amdgcn_s_sleep(1); \
    if ((++_sp & 255u) == 0u) { if (xb_ld(&(bar)[XB_TMO])) break; if (_sp > XB_SPIN_CAP) { atomicAdd(&(bar)[XB_TMO], 1u); break; } } } } while (0)

__device__ __forceinline__ void xcd_barrier_complete(unsigned* bar, unsigned x, unsigned& nloc, unsigned& nx) {
    const unsigned G = gridDim.x * gridDim.y * gridDim.z;
    unsigned sum, cnt, mine, sp = 0u;
    for (;;) {
        sum = 0u; cnt = 0u; mine = 0u;
#pragma unroll
        for (unsigned j = 0; j < 16; ++j) { const unsigned c = xb_ld(&bar[XB_XCNT(j)]); sum += c; cnt += (c > 0u) ? 1u : 0u; mine = (j == x) ? c : mine; }
        if (sum == G) break;
        __builtin_amdgcn_s_sleep(1);
        if ((++sp & 255u) == 0u) { if (xb_ld(&bar[XB_TMO])) break; if (sp > XB_SPIN_CAP) { atomicAdd(&bar[XB_TMO], 1u); break; } }
    }
    nloc = mine > 0u ? mine : 1u; nx = cnt > 0u ? cnt : 1u;
}
__device__ __forceinline__ void xcd_barrier(unsigned* bar, volatile LAS unsigned* st, bool leader) {
    asm volatile("s_waitcnt vmcnt(0)" ::: "memory");
    __syncthreads();
    if (leader) {
        const unsigned x = xb_xcc_id();
        __builtin_amdgcn_s_waitcnt(0);
        unsigned nloc = st[0], nx = st[1];
        if (nloc == 0u) { xcd_barrier_complete(bar, x, nloc, nx); st[0] = nloc; st[1] = nx; }
        const unsigned old = xb_add(&bar[XB_XSUB(x)], 1u);
        const unsigned gen = old / nloc;
        if (old + 1u == (gen + 1u) * nloc) {
            __builtin_amdgcn_fence(__ATOMIC_RELEASE, "agent");
            asm volatile("s_waitcnt vmcnt(0)" ::: "memory");
            const unsigned og = xb_add(&bar[XB_TOP], 1u);
            const unsigned tg = og / nx;
            if (og + 1u == (tg + 1u) * nx) xb_add(&bar[XB_TOPGEN], 1u);
            else XB_SPIN(xb_ld(&bar[XB_TOPGEN]) == tg, bar);
            __builtin_amdgcn_fence(__ATOMIC_ACQUIRE, "agent");
            xb_add(&bar[XB_XGEN(x)], 1u);
            asm volatile("s_waitcnt vmcnt(0)" ::: "memory");
        } else {
            XB_SPIN(xb_ld(&bar[XB_XGEN(x)]) == gen, bar);
            __builtin_amdgcn_fence(__ATOMIC_ACQUIRE, "agent");
            asm volatile("s_waitcnt vmcnt(0)" ::: "memory");
        }
    }
    __syncthreads();
}

struct Params {
    const float* x; const float* f1_pre_g; const float* f1_wg; const float* f1_wu; const float* f1_wd; const float* f1_post_g;
    const float* mix_pre_g; const float* w_in; const float* b_forget; const float* ln_g; const float* ln_b; const float* w_s; const float* b_s;
    const float* w_out; const float* mix_post_g; const float* f2_pre_g; const float* f2_wg; const float* f2_wu; const float* f2_wd; const float* f2_post_g;
    float* out; unsigned char* ws;
};

__device__ __forceinline__ void tr_item(const float* __restrict__ W, int ldn, int K, int scol, bf16u* WT, int drow, const float* __restrict__ g, LAS float* scr, int k0, int lane) {
    float v[32];
    const float* src = W + (size_t)(k0 + (lane >> 5)) * ldn + scol + (lane & 31);
#pragma unroll
    for (int i = 0; i < 32; ++i) v[i] = src[(size_t)(2 * i) * ldn];
    const int c = lane & 7;
    v4f g0 = (v4f){1.f, 1.f, 1.f, 1.f}, g1 = g0;
    if (g) { g0 = *(const v4f*)(g + k0 + 8 * c); g1 = *(const v4f*)(g + k0 + 8 * c + 4); }
#pragma unroll
    for (int i = 0; i < 32; ++i) scr[(2 * i + (lane >> 5)) * 33 + (lane & 31)] = v[i];
    asm volatile("s_waitcnt lgkmcnt(0)" ::: "memory");
#pragma unroll
    for (int j = 0; j < 4; ++j) { const int n = (lane >> 3) + 8 * j; const LAS float* s = scr + (8 * c) * 33 + n;
        v4u o; o.x = pk2(s[0 * 33] * g0.x, s[1 * 33] * g0.y); o.y = pk2(s[2 * 33] * g0.z, s[3 * 33] * g0.w); o.z = pk2(s[4 * 33] * g1.x, s[5 * 33] * g1.y); o.w = pk2(s[6 * 33] * g1.z, s[7 * 33] * g1.w);
        *(v4u*)(WT + (size_t)(drow + n) * K + k0 + 8 * c) = o; }
    asm volatile("s_waitcnt lgkmcnt(0)" ::: "memory");
}

typedef const CAS Params* PP;
__device__ __forceinline__ int fresh_tid(int wave_s) { int t = 0; asm volatile("" : "+v"(t)); t = wave_s * 64 + (int)__builtin_amdgcn_mbcnt_hi(~0u, __builtin_amdgcn_mbcnt_lo(~0u, (unsigned)t)); asm volatile("" : "+v"(t)); return t;     }
__device__ __forceinline__ void p0_prologue(PP p, LAS unsigned char* lds, int gw, int NGW, int lane, int wave, int gtid, int NGT) {
    unsigned char* ws = p->ws;
    LAS float* scr = (LAS float*)(lds + wave * 16384);
    constexpr int I_G = 16 * 128, I_D = 64 * 32, I_IN = 16 * 224, I_O = 16 * 32;
    constexpr int NITEMS = 2 * (2 * I_G + I_D) + I_IN + I_O;
    for (int it = gw; it < NITEMS; it += NGW) {
        int r = it;
        if (r < 2 * I_G) { const bool up = r >= I_G; if (up) r -= I_G; const int kb = r >> 7, nb = r & 127, n0 = nb * 32;
            tr_item(up ? p->f1_wu : p->f1_wg, FF, DM, n0, (bf16u*)(ws + WS_WGU1), (n0 >> 7) * 256 + (n0 & 127) + (up ? 128 : 0), p->f1_pre_g, scr, kb * 64, lane); continue; }
        r -= 2 * I_G;
        if (r < I_D) { const int kb = r >> 5, nb = r & 31; tr_item(p->f1_wd, DM, FF, nb * 32, (bf16u*)(ws + WS_WD1), nb * 32, nullptr, scr, kb * 64, lane); continue; }
        r -= I_D;
        if (r < I_IN) { const int kb = r / 224, nb = r % 224, d0 = nb * 32;
            const int sc = d0 < 2048 ? d0 + 1024 : d0 < 3072 ? d0 - 2048 : d0 < 4096 ? 5128 + (d0 - 3072) : d0 < 5120 ? 3080 + (d0 - 4096) : d0 < 6144 ? 4104 + (d0 - 5120) : 6152 + (d0 - 6144);
            tr_item(p->w_in, INW, DM, sc, (bf16u*)(ws + WS_WIN), d0, p->mix_pre_g, scr, kb * 64, lane); continue; }
        r -= I_IN;
        if (r < I_O) { const int kb = r >> 5, nb = r & 31; tr_item(p->w_out, DM, DM, nb * 32, (bf16u*)(ws + WS_WOUT), nb * 32, nullptr, scr, kb * 64, lane); continue; }
        r -= I_O;
        if (r < 2 * I_G) { const bool up = r >= I_G; if (up) r -= I_G; const int kb = r >> 7, nb = r & 127, n0 = nb * 32;
            tr_item(up ? p->f2_wu : p->f2_wg, FF, DM, n0, (bf16u*)(ws + WS_WGU2), (n0 >> 7) * 256 + (n0 & 127) + (up ? 128 : 0), p->f2_pre_g, scr, kb * 64, lane); continue; }
        r -= 2 * I_G;
        { const int kb = r >> 5, nb = r & 31; tr_item(p->f2_wd, DM, FF, nb * 32, (bf16u*)(ws + WS_WD2), nb * 32, nullptr, scr, kb * 64, lane); }
    }
    float* Wf = (float*)(ws + WS_WF);
    for (int i = gtid; i < 8 * DM; i += NGT) { const int h = i >> 10, k = i & 1023; Wf[i] = p->w_in[(size_t)k * INW + 3072 + h] * p->mix_pre_g[k]; }
    bf16u* Wsm = (bf16u*)(ws + WS_WSM);
    for (int i = gtid; i < 8 * 128 * 128; i += NGT) { const int t = (i >> 7) & 127, s = i & 127; Wsm[i] = (bf16u)((s >> 6) <= (t >> 6) ? f2bf(p->w_s[i]) : 0u); }
    bf16u* xb = (bf16u*)(ws + WS_R0); float* rstd0 = (float*)(ws + WS_RSTD0);
    { v4f xv[2][4];
#define P0_LOAD(row0_) do { _Pragma("unroll") for (int n = 0; n < 2; ++n) { const float* xr_ = p->x + (size_t)((row0_) + n * NGW) * DM + 8 * lane; _Pragma("unroll") for (int j = 0; j < 2; ++j) { xv[n][2 * j] = *(const v4f*)(xr_ + 512 * j); xv[n][2 * j + 1] = *(const v4f*)(xr_ + 512 * j + 4); } } } while (0)
      if (gw < T) P0_LOAD(gw);
      for (int row = gw; row < T; row += 2 * NGW) {
        v4f v[2][4]; float ss[2];
#pragma unroll
        for (int n = 0; n < 2; ++n) { float s = 0.f;
#pragma unroll
            for (int j = 0; j < 4; ++j) { v[n][j] = xv[n][j]; s += (v[n][j].x * v[n][j].x + v[n][j].y * v[n][j].y) + (v[n][j].z * v[n][j].z + v[n][j].w * v[n][j].w); }
            ss[n] = s; }
        if (row + 2 * NGW < T) P0_LOAD(row + 2 * NGW);
#pragma unroll
        for (int n = 0; n < 2; ++n) ss[n] = wave_sum(ss[n]);
#pragma unroll
        for (int n = 0; n < 2; ++n) { const int rw = row + n * NGW;
            if (lane == 0) rstd0[rw] = 1.0f / sqrtf(ss[n] * (1.0f / DM) + RMS_EPS);
#pragma unroll
            for (int j = 0; j < 2; ++j) { v4u o; o.x = pk2(v[n][2 * j].x, v[n][2 * j].y); o.y = pk2(v[n][2 * j].z, v[n][2 * j].w); o.z = pk2(v[n][2 * j + 1].x, v[n][2 * j + 1].y); o.w = pk2(v[n][2 * j + 1].z, v[n][2 * j + 1].w);
                *(v4u*)(xb + (size_t)rw * DM + 8 * lane + 512 * j) = o; } }
      }
#undef P0_LOAD
    }
}

template <int NR> __device__ __forceinline__ void row_pass(const float* res, const bf16u* resb, const bf16u* y, const float* __restrict__ gpost, float alpha, float* xout, bf16u* xbo, float* rstd_out,
                                         const LAS float* Wf_l, const float* b_forget, float* logf, int gw, int NGW, int lane) {
    v4f g[4];
#pragma unroll
    for (int j = 0; j < 2; ++j) { g[2 * j] = *(const v4f*)(gpost + 8 * lane + 512 * j); g[2 * j + 1] = *(const v4f*)(gpost + 8 * lane + 512 * j + 4); }
    v4u yw[NR][2], qw[NR][2]; v4f rf[NR][4];
#define RP_LOAD(row0_) do { _Pragma("unroll") for (int n = 0; n < NR; ++n) { const size_t ro_ = (size_t)((row0_) + n * NGW) * DM + 8 * lane; _Pragma("unroll") for (int j = 0; j < 2; ++j) { yw[n][j] = *(const v4u*)(y + ro_ + 512 * j); \
        if (res) { rf[n][2 * j] = *(const v4f*)(res + ro_ + 512 * j); rf[n][2 * j + 1] = *(const v4f*)(res + ro_ + 512 * j + 4); } else qw[n][j] = *(const v4u*)(resb + ro_ + 512 * j); } } } while (0)
    if (gw < T) RP_LOAD(gw);
    for (int row = gw; row < T; row += NR * NGW) {
        v4f r[NR][4], yv[NR][4];
#pragma unroll
        for (int n = 0; n < NR; ++n)
#pragma unroll
            for (int j = 0; j < 2; ++j) { const v4u w = yw[n][j]; yv[n][2 * j] = (v4f){bflo(w.x), bfhi(w.x), bflo(w.y), bfhi(w.y)}; yv[n][2 * j + 1] = (v4f){bflo(w.z), bfhi(w.z), bflo(w.w), bfhi(w.w)};
                if (res) { r[n][2 * j] = rf[n][2 * j]; r[n][2 * j + 1] = rf[n][2 * j + 1]; }
                else { const v4u q = qw[n][j]; r[n][2 * j] = (v4f){bflo(q.x), bfhi(q.x), bflo(q.y), bfhi(q.y)}; r[n][2 * j + 1] = (v4f){bflo(q.z), bfhi(q.z), bflo(q.w), bfhi(q.w)}; } }
        if (row + NR * NGW < T) RP_LOAD(row + NR * NGW);
        float ss[NR];
#pragma unroll
        for (int n = 0; n < NR; ++n) { float s = 0.f;
#pragma unroll
            for (int j = 0; j < 4; ++j) s += (yv[n][j].x * yv[n][j].x + yv[n][j].y * yv[n][j].y) + (yv[n][j].z * yv[n][j].z + yv[n][j].w * yv[n][j].w);
            ss[n] = s; }
#pragma unroll
        for (int n = 0; n < NR; ++n) ss[n] = wave_sum(ss[n]);
#pragma unroll
        for (int n = 0; n < NR; ++n) { const float sc = alpha / sqrtf(ss[n] * (1.0f / DM) + RMS_EPS);
#pragma unroll
            for (int j = 0; j < 4; ++j) r[n][j] = r[n][j] + (yv[n][j] * sc) * g[j]; }
        if (xout) {
#pragma unroll
            for (int n = 0; n < NR; ++n) { const size_t ro = (size_t)(row + n * NGW) * DM + 8 * lane;
#pragma unroll
                for (int j = 0; j < 2; ++j) { *(v4f*)(xout + ro + 512 * j) = r[n][2 * j]; *(v4f*)(xout + ro + 512 * j + 4) = r[n][2 * j + 1]; } } }
        if (xbo) {
            float s2[NR], rs[NR];
#pragma unroll
            for (int n = 0; n < NR; ++n) { float s = 0.f;
#pragma unroll
                for (int j = 0; j < 4; ++j) s += (r[n][j].x * r[n][j].x + r[n][j].y * r[n][j].y) + (r[n][j].z * r[n][j].z + r[n][j].w * r[n][j].w);
                s2[n] = s; }
#pragma unroll
            for (int n = 0; n < NR; ++n) s2[n] = wave_sum(s2[n]);
#pragma unroll
            for (int n = 0; n < NR; ++n) { rs[n] = 1.0f / sqrtf(s2[n] * (1.0f / DM) + RMS_EPS); const size_t ro = (size_t)(row + n * NGW) * DM + 8 * lane;
                if (lane == 0) rstd_out[row + n * NGW] = rs[n];
#pragma unroll
                for (int j = 0; j < 2; ++j) { v4u o; o.x = pk2(r[n][2 * j].x, r[n][2 * j].y); o.y = pk2(r[n][2 * j].z, r[n][2 * j].w); o.z = pk2(r[n][2 * j + 1].x, r[n][2 * j + 1].y); o.w = pk2(r[n][2 * j + 1].z, r[n][2 * j + 1].w);
                    *(v4u*)(xbo + ro + 512 * j) = o; } }
            if (logf) {
#pragma unroll
                for (int n = 0; n < NR; ++n) {
                    float d8[8];
#pragma unroll
                    for (int h = 0; h < 8; ++h) { const LAS float* wf = Wf_l + h * DM + 8 * lane; float d = 0.f;
#pragma unroll
                        for (int j = 0; j < 2; ++j) { const v4f a = *(const LAS v4f*)(wf + 512 * j), b = *(const LAS v4f*)(wf + 512 * j + 4);
                            d += (r[n][2 * j].x * a.x + r[n][2 * j].y * a.y) + (r[n][2 * j].z * a.z + r[n][2 * j].w * a.w) + (r[n][2 * j + 1].x * b.x + r[n][2 * j + 1].y * b.y) + (r[n][2 * j + 1].z * b.z + r[n][2 * j + 1].w * b.w); }
                        d8[h] = d; }
#pragma unroll
                    for (int h = 0; h < 8; ++h) d8[h] += dpp_f<0xB1>(d8[h]);
#pragma unroll
                    for (int h = 0; h < 8; ++h) d8[h] += dpp_f<0x4E>(d8[h]);
#pragma unroll
                    for (int h = 0; h < 8; ++h) d8[h] += dpp_f<0x141>(d8[h]);
#pragma unroll
                    for (int h = 0; h < 8; ++h) d8[h] += dpp_f<0x140>(d8[h]);
#pragma unroll
                    for (int h = 0; h < 8; ++h) d8[h] += swz_xor<16>(d8[h]);
#pragma unroll
                    for (int h = 0; h < 8; ++h) { auto rr = __builtin_amdgcn_permlane32_swap(__float_as_uint(d8[h]), __float_as_uint(d8[h]), false, false); d8[h] = __uint_as_float(rr[0]) + __uint_as_float(rr[1]); }
                    float dsel = d8[0];
#pragma unroll
                    for (int h = 1; h < 8; ++h) dsel = lane == h ? d8[h] : dsel;
                    if (lane < 8) { const float z = dsel * rs[n] + b_forget[lane]; const float ls = fminf(z, 0.f) - log1pf(expf(-fabsf(z))); logf[(size_t)lane * T + row + n * NGW] = ls; }
                }
            }
        }
    }
}

#undef RP_LOAD
__device__ __forceinline__ void cumsum_phase(const float* logf, float* kbias, LAS unsigned char* lds, int bx, int tid, int lane, int wave) {
    if (bx < 32) {
        const int b = bx >> 3, h = bx & 7; LAS float* wt = (LAS float*)lds;
        float v[16]; float run = 0.f;
#pragma unroll
        for (int i = 0; i < 16; ++i) { run += logf[(size_t)h * T + (size_t)b * SEQ + tid * 16 + i]; v[i] = run; }
        float incl = run;
#pragma unroll
        for (int o = 1; o < 64; o <<= 1) { const float t = __int_as_float(__builtin_amdgcn_ds_bpermute(((lane - o) & 63) << 2, __float_as_int(incl))); if (lane >= o) incl += t; }
        if (lane == 63) wt[wave] = incl;
        __syncthreads();
        float base = incl - run;
        for (int w = 0; w < wave; ++w) base += wt[w];
#pragma unroll
        for (int i = 0; i < 16; ++i) kbias[(size_t)bx * SEQ + tid * 16 + i] = -(base + v[i]) * 11.313708498984761f;
    }
    __syncthreads();
}

__device__ __forceinline__ void sgu_phase(PP p, LAS unsigned char* lds, bf16u* U, const bf16u* SV, const bf16u* GB, const bf16u* Wsm, int G, int bx, int tid, int lane, int wave) {
    LAS bf16u* vnT = (LAS bf16u*)lds;
    const int r32 = lane & 31, hi = lane >> 5;
    for (int unit = bx; unit < 2048; unit += G) {
        const int g = unit & 7, win = unit >> 3; const size_t row0 = (size_t)win * 128; const int col0 = g * 128;
        const int tb = (wave & 3) * 32, cbw = (wave >> 2) * 64;
        unsigned short uu[16][2], gg[16][2]; float bsv[16];
            bf16u* ub = U + (row0 + tb) * DM + col0 + cbw; const bf16u* gbp = GB + (row0 + tb) * DM + col0 + cbw; const float* bsp = p->b_s + g * 128 + tb;
            const unsigned eo = (unsigned)(hi * 4 * DM + r32);
#pragma unroll
            for (int r = 0; r < 16; ++r) { const int tc = (r & 3) + 8 * (r >> 2), co = tc * DM; bsv[r] = bsp[tc + 4 * hi];
                uu[r][0] = (ub + co)[eo]; uu[r][1] = (ub + co + 32)[eo]; gg[r][0] = (gbp + co)[eo]; gg[r][1] = (gbp + co + 32)[eo]; }
        { const int r = tid >> 2, q = tid & 3; const bf16u* src = (SV + row0 * DM + col0) + (unsigned)(r * DM + q * 32);
            float v[32];
#pragma unroll
            for (int i = 0; i < 4; ++i) { const v4u w = *(const v4u*)(src + 8 * i);
                v[8 * i] = bflo(w.x); v[8 * i + 1] = bfhi(w.x); v[8 * i + 2] = bflo(w.y); v[8 * i + 3] = bfhi(w.y); v[8 * i + 4] = bflo(w.z); v[8 * i + 5] = bfhi(w.z); v[8 * i + 6] = bflo(w.w); v[8 * i + 7] = bfhi(w.w); }
            float s = 0.f;
#pragma unroll
            for (int i = 0; i < 32; ++i) s += v[i];
            s += swz_xor<1>(s); s += swz_xor<2>(s);
            const float mu = s * (1.0f / 128.0f); float q2 = 0.f;
#pragma unroll
            for (int i = 0; i < 32; ++i) { v[i] -= mu; q2 += v[i] * v[i]; }
            q2 += swz_xor<1>(q2); q2 += swz_xor<2>(q2);
            const float rs = 1.0f / sqrtf(q2 * (1.0f / 128.0f) + LN_EPS);
            const float* lg = p->ln_g + col0 + q * 32; const float* lb = p->ln_b + col0 + q * 32;
#pragma unroll
            for (int i = 0; i < 32; ++i) vnT[(q * 32 + i) * 136 + r] = (bf16u)f2bf(v[i] * rs * lg[i] + lb[i]);
        }
        v8s afr[8];
        { const bf16u* wa = Wsm + ((size_t)(g * 128 + tb + r32)) * 128 + 8 * hi;
#pragma unroll
          for (int kk = 0; kk < 8; ++kk) afr[kk] = *(const v8s*)(wa + 16 * kk); }
        __syncthreads();
        v16f acc0 = {}, acc1 = {};
        const LAS bf16u* vb0 = vnT + (cbw + r32) * 136 + 8 * hi; const LAS bf16u* vb1 = vb0 + 32 * 136;
#pragma unroll
        for (int kk = 0; kk < 8; ++kk) { const v8s a = afr[kk]; const v8s b0 = *(const LAS v8s*)(vb0 + 16 * kk), b1 = *(const LAS v8s*)(vb1 + 16 * kk);
            acc0 = __builtin_amdgcn_mfma_f32_32x32x16_bf16(a, b0, acc0, 0, 0, 0); acc1 = __builtin_amdgcn_mfma_f32_32x32x16_bf16(a, b1, acc1, 0, 0, 0); }
        {
            __builtin_amdgcn_sched_barrier(0);
#pragma unroll
            for (int r = 0; r < 16; ++r) { const int co = ((r & 3) + 8 * (r >> 2)) * DM;
                const float u0 = __uint_as_float((unsigned)uu[r][0] << 16), u1 = __uint_as_float((unsigned)uu[r][1] << 16), g0 = __uint_as_float((unsigned)gg[r][0] << 16), g1 = __uint_as_float((unsigned)gg[r][1] << 16);
                (ub + co)[eo] = (bf16u)f2bf(g0 * u0 * (acc0[r] + bsv[r])); (ub + co + 32)[eo] = (bf16u)f2bf(g1 * u1 * (acc1[r] + bsv[r])); } }
        __syncthreads();
    }
}

__device__ __forceinline__ void attn_phase(unsigned char* lds_g, LAS unsigned char* lds, bf16u* Qb, const bf16u* Kb, const bf16u* Vb, const bf16u* GAb, const bf16u* OBb, const float* kbias, unsigned* ctl, int wave_s) {
    const LAS float* kbl = (const LAS float*)(lds + att::KB_OFF);
    att::FoxCtx cx; cx.Qb = Qb; cx.Kb = Kb; cx.Vb = Vb; cx.GAb = GAb; cx.OBb = OBb; cx.kbias = kbias; cx.ctl = ctl; cx.slot = (volatile LAS unsigned*)(lds + LDS_MISC + 16);
    int tid = fresh_tid(wave_s);
    if (tid == 0) cx.slot[0] = att::fox_fetch(ctl);
    __syncthreads();
    const int n_cur = __builtin_amdgcn_readfirstlane((int)cx.slot[0]);
    __syncthreads();
    if (n_cur >= 1024) return;
    att::BlockRef cur = att::fox_mkref(n_cur, cx, tid & 63);
    att::Seam S;
    bool first = true;
    for (;;) {
        tid = fresh_tid(wave_s);
        { const float* kbg = kbias + (size_t)cur.bh * SEQ; LAS float* kw = (LAS float*)(lds + att::KB_OFF); const int n = cur.P0 + 256;
            for (int i = cur.jlo * 64 + tid * 4; i < n; i += 2048) *(LAS v4f*)(kw + i) = *(const v4f*)(kbg + i);
            __syncthreads(); }
        if (first) { att::fox_prime(cur, (char*)lds_g, S, wave_s); first = false; }
        att::BlockRef nxt; bool last;
        att::fox_block(cur, nxt, last, cx, (char*)lds_g, kbl, S, wave_s);
        if (last) break;
        cur = nxt;
    }
}

#ifndef DOUBLE_STEP
#define DOUBLE_STEP -1
#endif
__global__ void __launch_bounds__(512, 2) fox_gmlp_fwd(Params p_unused) {
    extern __shared__ __attribute__((aligned(16))) unsigned char lds_raw[];
    cg::grid_group grid = cg::this_grid();
    LAS unsigned char* lds = (LAS unsigned char*)lds_raw;
    const int G = gridDim.x, bx = blockIdx.x, NGW = G * 8, NGT = G * 512;
    const int wave_s = __builtin_amdgcn_readfirstlane((int)threadIdx.x >> 6);
    volatile LAS unsigned* bst = (volatile LAS unsigned*)(lds + LDS_MISC);
    if (threadIdx.x < 2) bst[threadIdx.x] = 0u;
    grid.sync();
    { PP p0 = (PP)__builtin_amdgcn_kernarg_segment_ptr(); if (threadIdx.x == 0) (void)xb_add((unsigned*)(p0->ws + WS_BAR) + XB_XCNT(xb_xcc_id()), 1u); }
#pragma unroll 1
    for (int it = 0; it < 13 + (DOUBLE_STEP >= 0 ? 1 : 0); ++it) {
        const int step = (DOUBLE_STEP >= 0 && it > DOUBLE_STEP) ? it - 1 : it;
        const int tid = fresh_tid(wave_s);
        const int lane = tid & 63, wave = wave_s, gw = bx * 8 + wave, gtid = bx * 512 + tid;
        PP p = (PP)__builtin_amdgcn_kernarg_segment_ptr(); asm volatile("" : "+s"(p));
        unsigned char* ws = p->ws;
        bf16u* R0 = (bf16u*)(ws + WS_R0); bf16u* S0 = (bf16u*)(ws + WS_S0); bf16u* S1 = (bf16u*)(ws + WS_S1); bf16u* S2 = (bf16u*)(ws + WS_S2); bf16u* S3 = (bf16u*)(ws + WS_S3); bf16u* S4 = (bf16u*)(ws + WS_S4);
        float* rstd0 = (float*)(ws + WS_RSTD0); float* rstd1 = (float*)(ws + WS_RSTD1); float* rstd2 = (float*)(ws + WS_RSTD2);
        float* logf = (float*)(ws + WS_LOGF); float* kbias = (float*)(ws + WS_KBIAS);
        if (step == 0) {
            p0_prologue(p, lds, gw, NGW, lane, wave, gtid, NGT);
        } else if (step == 1 || step == 10) {
            const bool second = step == 10;
            pg8::Gemm g{R0, (const bf16u*)(ws + (second ? WS_WGU2 : WS_WGU1)), T, 2 * FF, DM}; pg8::StaticOrder S; S.init(T, 2 * FF, G, bx);
            pg8::EpiSwiGLU E{S0, second ? rstd2 : rstd0};
            pg8::gemm_phase<pg8::EpiSwiGLU, pg8::StaticOrder, true, true>(lds, g, S, E, wave_s);
        } else if (step == 2 || step == 8 || step == 11) {
            const bf16u* A = step == 8 ? S3 : S0; const bf16u* Bt = (const bf16u*)(ws + (step == 2 ? WS_WD1 : step == 8 ? WS_WOUT : WS_WD2));
            bf16u* Y = step == 8 ? S0 : S4; const int K = step == 8 ? DM : FF;
            pg8::Gemm g{A, Bt, T, DM, K}; pg8::StaticOrder S; S.init(T, DM, G, bx);
            pg8::EpiBf16<0> E{Y, DM, nullptr, 0, 0, 1.f};
            pg8::gemm_phase<pg8::EpiBf16<0>, pg8::StaticOrder, true, true>(lds, g, S, E, wave_s);
        } else if (step == 3 || step == 9 || step == 12) {
            if (step == 3) {
                LAS float* wfl = (LAS float*)lds; const float* Wf = (const float*)(ws + WS_WF);
                for (int i = tid * 4; i < 8 * DM; i += 2048) *(LAS v4f*)(wfl + i) = *(const v4f*)(Wf + i);
                __syncthreads();
                row_pass<1>(p->x, nullptr, S4, p->f1_post_g, 0.5f, nullptr, R0, rstd1, wfl, p->b_forget, logf, gw, NGW, lane);
            } else if (step == 9) {
                row_pass<2>(nullptr, R0, S0, p->mix_post_g, 1.0f, nullptr, R0, rstd2, nullptr, nullptr, nullptr, gw, NGW, lane);
            } else {
                row_pass<2>(nullptr, R0, S4, p->f2_post_g, 0.5f, p->out, nullptr, nullptr, nullptr, nullptr, nullptr, gw, NGW, lane);
            }
        } else if (step == 4 || step == 6) {
            if (step == 4) cumsum_phase(logf, kbias, lds, bx, tid, lane, wave);
            const bool a = step == 4;
            pg8::Gemm g{R0, (const bf16u*)(ws + WS_WIN) + (a ? (size_t)4096 * DM : 0), T, a ? 3072 : 4096, DM}; pg8::StaticOrder S; S.init(T, a ? 3072 : 4096, G, bx);
            pg8::EpiMix E{a ? S0 : S1, (size_t)32 * MiB, a ? 0 : 1, rstd1, (unsigned*)(ws + WS_BAR) + att::CW_NRM};
            pg8::gemm_phase<pg8::EpiMix, pg8::StaticOrder, true, true>(lds, g, S, E, wave_s);
        } else if (step == 5) {
            sgu_phase(p, lds, S0, S1, S2, (const bf16u*)(ws + WS_WSM), G, bx, tid, lane, wave);
        } else if (step == 7) {
            attn_phase(lds_raw, lds, S3, S1, S2, S4, S0, kbias, (unsigned*)(ws + WS_BAR), wave_s);
        }
        if (it != 12 + (DOUBLE_STEP >= 0 ? 1 : 0)) xcd_barrier((unsigned*)(ws + WS_BAR), bst, wave_s == 0 && lane == 0);
    }
}

extern "C" void kernel_launch(void* const* d_in, const int* in_sizes, int n_in, void* d_out, int out_size, void* d_ws, size_t ws_size, hipStream_t stream) {
    static int grid = 0;
    if (grid == 0) {
        if (n_in != 20 || in_sizes[0] != T * DM || out_size != T * DM || ws_size < WS_END) {
            fprintf(stderr, "kernel_launch: unexpected shapes (n_in %d, in0 %d, out %d, ws %zu); nothing launched\n", n_in, n_in > 0 ? in_sizes[0] : -1, out_size, ws_size); grid = -1; return; }
        int dev = 0, cus = 0, per_cu = 0;
        (void)hipGetDevice(&dev); (void)hipDeviceGetAttribute(&cus, hipDeviceAttributeMultiprocessorCount, dev);
        if (hipFuncSetAttribute((const void*)fox_gmlp_fwd, hipFuncAttributeMaxDynamicSharedMemorySize, LDS_TOTAL) != hipSuccess) { fprintf(stderr, "kernel_launch: hipFuncSetAttribute failed\n"); grid = -1; return; }
        if (hipOccupancyMaxActiveBlocksPerMultiprocessor(&per_cu, (const void*)fox_gmlp_fwd, 512, LDS_TOTAL) != hipSuccess || per_cu < 1) { fprintf(stderr, "kernel_launch: occupancy query says %d\n", per_cu); per_cu = 1; }
        (void)hipGetLastError();
        if (per_cu > 1) per_cu = 1;
        grid = cus * per_cu;
    }
    if (grid < 0) return;
    Params p{};
    p.x = (const float*)d_in[0]; p.f1_pre_g = (const float*)d_in[1]; p.f1_wg = (const float*)d_in[2]; p.f1_wu = (const float*)d_in[3]; p.f1_wd = (const float*)d_in[4]; p.f1_post_g = (const float*)d_in[5];
    p.mix_pre_g = (const float*)d_in[6]; p.w_in = (const float*)d_in[7]; p.b_forget = (const float*)d_in[8]; p.ln_g = (const float*)d_in[9]; p.ln_b = (const float*)d_in[10]; p.w_s = (const float*)d_in[11]; p.b_s = (const float*)d_in[12];
    p.w_out = (const float*)d_in[13]; p.mix_post_g = (const float*)d_in[14]; p.f2_pre_g = (const float*)d_in[15]; p.f2_wg = (const float*)d_in[16]; p.f2_wu = (const float*)d_in[17]; p.f2_wd = (const float*)d_in[18]; p.f2_post_g = (const float*)d_in[19];
    p.out = (float*)d_out; p.ws = (unsigned char*)d_ws;
    if (hipMemsetAsync((char*)d_ws + WS_BAR, 0, BAR_BYTES, stream) != hipSuccess) { fprintf(stderr, "kernel_launch: hipMemsetAsync failed\n"); return; }
    void* args[] = {&p};
    hipError_t e = hipLaunchCooperativeKernel((const void*)fox_gmlp_fwd, dim3(grid), dim3(512), args, LDS_TOTAL, stream);
    if (e != hipSuccess) fprintf(stderr, "kernel_launch: cooperative launch failed: %s (grid %d)\n", hipGetErrorString(e), grid);
}
```

```cpp
#include <hip/hip_runtime.h>
#include <hip/hip_cooperative_groups.h>
#include <hip/hip_bf16.h>
#include <cstdio>
#include <cstdint>
namespace cg = cooperative_groups;
namespace pg8 {
#define PG8_LAS __attribute__((address_space(3)))
typedef unsigned short bf16_t;
typedef short bf16x8 __attribute__((ext_vector_type(8)));
typedef float f32x4 __attribute__((ext_vector_type(4)));
typedef unsigned u32x4 __attribute__((ext_vector_type(4)));
constexpr int BM = 256, BK = 64, HALF = 128, HTB = HALF * BK * 2  , STAGE_BYTES = 8 * HTB, NXCD = 8, WGM = 8;

__host__ __device__ __forceinline__ int lds_byte(int r, int c) { const int st = (r >> 4) * 2 + (c >> 5), rr = r & 15, cc = c & 31, ob = rr * 64 + cc * 2; return st * 1024 + (ob ^ (((ob >> 9) & 1) << 5)); }
__host__ __device__ __forceinline__ void stage_rc(int b, int& R, int& C) { const int st = b / 1024, sb = b % 1024, swz = sb ^ (((sb >> 9) & 1) << 5); R = (st >> 1) * 16 + swz / 64; C = (st & 1) * 32 + (swz % 64) / 2; }
__host__ __device__ __forceinline__ int perm32(int rho) { const int n = rho >> 4, i = rho & 15; return 8 * (i >> 2) + 4 * n + (i & 3); }

struct Unit { int pm, pn; };
struct Gemm { const bf16_t* A; const bf16_t* Bt; int M, N, K; };

struct StaticOrder {
    int nM, nN, nwg, G, c;
    __host__ __device__ void init(int M, int N, int G_, int c_) { nM = M / BM; nN = N / BM; nwg = nM * nN; G = G_; c = c_; }
    __host__ __device__ bool next(int i, Unit& u) const {
        const long L = (long)i * G + c; if (L >= nwg) return false;
        int wgid = (int)L; { const int q = nwg / NXCD, r = nwg % NXCD, xcd = wgid % NXCD, off = wgid / NXCD; wgid = (xcd < r ? xcd * (q + 1) : r * (q + 1) + (xcd - r) * q) + off; }
        const int nig = WGM * nN, gid = wgid / nig, fm = gid * WGM, gsz = (nM - fm) < WGM ? (nM - fm) : WGM;
        u.pm = fm + ((wgid % nig) % gsz); u.pn = (wgid % nig) / gsz; return true;
    }
    __device__ __forceinline__ void a_ready(const Unit&) const {}
    __device__ __forceinline__ void done(const Unit&) const {}
};

typedef float cvt_f32x2 __attribute__((ext_vector_type(2))); typedef __bf16 cvt_bf16x2 __attribute__((ext_vector_type(2)));
__device__ __forceinline__ unsigned cvt_pk_bf16(float lo, float hi) { cvt_f32x2 v = {lo, hi}; cvt_bf16x2 b = __builtin_convertvector(v, cvt_bf16x2); return __builtin_bit_cast(unsigned, b); }
typedef float f32x2 __attribute__((ext_vector_type(2)));
__device__ __forceinline__ f32x2 gelu_pk(f32x2 v) {
    const f32x2 av = __builtin_elementwise_abs(v), d = av * 0.2316418882f + 1.0f;
    f32x2 t; t.x = __builtin_amdgcn_rcpf(d.x); t.y = __builtin_amdgcn_rcpf(d.y);
    f32x2 q = t * 0.5307027145f + (-0.7265760135f); q = q * t + 0.7107068705f; q = q * t + (-0.142248368f); q = q * t + 0.127414796f; q = q * t;
    const f32x2 s = (v * v) * (-0.72134752044f);
    f32x2 e; e.x = __builtin_amdgcn_exp2f(s.x); e.y = __builtin_amdgcn_exp2f(s.y);
    const f32x2 m = v * (q * e), r = v - m;
    f32x2 o; o.x = v.x < 0.f ? m.x : r.x; o.y = v.y < 0.f ? m.y : r.y; return o;
}

template <int ACT  > struct EpiBf16 {
    static constexpr bool PERM = true, AFTER_DRAIN = false, RSTD_LDS = false; static_assert(ACT == 0 || ACT == 1, "EpiBf16: ACT is 0 (none) or 1 (gelu_pk)");
    bf16_t* O; int ldc; const float* bias; int split_cols; size_t split_stride; float scale0;
    __device__ __forceinline__ void operator()(const f32x4 (&acc)[2][2][4][2], const Unit& u, int wr, int wc, int fr, int fq) const {
        const int row0 = u.pm * BM + wr * 64 + fr; int colt = u.pn * BM; bf16_t* base = O;
        float sc = 1.f; if (split_cols) { const int t = colt / split_cols; base += (size_t)t * split_stride; colt -= t * split_cols; if (t == 0) sc = scale0; }
        const int col0 = colt + wc * 32 + 8 * fq, bcol0 = u.pn * BM + wc * 32 + 8 * fq;
        f32x4 bv[2][2];
#pragma unroll
        for (int bj = 0; bj < 2; ++bj)
#pragma unroll
            for (int n = 0; n < 2; ++n) bv[bj][n] = bias ? *(const f32x4*)(bias + bcol0 + bj * HALF + 4 * n) : (f32x4){0.f, 0.f, 0.f, 0.f};
#pragma unroll
        for (int ai = 0; ai < 2; ++ai)
#pragma unroll
            for (int m = 0; m < 4; ++m) { bf16_t* rowp = base + (size_t)(row0 + ai * HALF + m * 16) * ldc + col0;
#pragma unroll
                for (int bj = 0; bj < 2; ++bj) { f32x4 v0 = acc[ai][bj][m][0] + bv[bj][0], v1 = acc[ai][bj][m][1] + bv[bj][1];
                    if (ACT == 1) { f32x2 a = gelu_pk((f32x2){v0[0], v0[1]}), b = gelu_pk((f32x2){v0[2], v0[3]}), c = gelu_pk((f32x2){v1[0], v1[1]}), d = gelu_pk((f32x2){v1[2], v1[3]});
                        v0 = (f32x4){a.x, a.y, b.x, b.y}; v1 = (f32x4){c.x, c.y, d.x, d.y}; }
                    v0 = v0 * sc; v1 = v1 * sc; u32x4 w; w.x = cvt_pk_bf16(v0[0], v0[1]); w.y = cvt_pk_bf16(v0[2], v0[3]); w.z = cvt_pk_bf16(v1[0], v1[1]); w.w = cvt_pk_bf16(v1[2], v1[3]);
                    *(u32x4*)(rowp + bj * HALF) = w; } }
    }
};

__device__ __forceinline__ float sigmoid_f(float x) { return __builtin_amdgcn_rcpf(1.0f + __builtin_amdgcn_exp2f(-1.4426950408889634f * x)); }
struct EpiSwiGLU {
    static constexpr bool PERM = true, AFTER_DRAIN = false, RSTD_LDS = true;
    bf16_t* O; const float* rstd;
    __device__ __forceinline__ void operator()(const f32x4 (&acc)[2][2][4][2], const Unit& u, int wr, int wc, int fr, int fq, const PG8_LAS float* rl) const {
        const int row0 = u.pm * BM + wr * 64 + fr, col0 = u.pn * HALF + wc * 32 + 8 * fq; rl += wr * 64 + fr;
#pragma unroll
        for (int ai = 0; ai < 2; ++ai)
#pragma unroll
            for (int m = 0; m < 4; ++m) { const int row = row0 + ai * HALF + m * 16; const float rs = rl[ai * HALF + m * 16];
                u32x4 w; unsigned wv[4];
#pragma unroll
                for (int n = 0; n < 2; ++n) { const f32x4 g = acc[ai][0][m][n] * rs, up = acc[ai][1][m][n] * rs; float o[4];
#pragma unroll
                    for (int j = 0; j < 4; ++j) o[j] = g[j] * sigmoid_f(g[j]) * up[j];
                    wv[2 * n] = cvt_pk_bf16(o[0], o[1]); wv[2 * n + 1] = cvt_pk_bf16(o[2], o[3]); }
                w.x = wv[0]; w.y = wv[1]; w.z = wv[2]; w.w = wv[3];
                *(u32x4*)(O + (size_t)row * 4096 + col0) = w; }
    }
};
struct EpiMix {
    static constexpr bool PERM = true, AFTER_DRAIN = false, RSTD_LDS = true;
    bf16_t* O; size_t stride; int mode; const float* rstd;
    unsigned* nrm;
    template <int ACT> __device__ __forceinline__ void body(const f32x4 (&acc)[2][2][4][2], bf16_t* base, int row0, int col0, const PG8_LAS float* rl) const {
#pragma unroll
        for (int ai = 0; ai < 2; ++ai)
#pragma unroll
            for (int m = 0; m < 4; ++m) { const int row = row0 + ai * HALF + m * 16; const float rs = rl[ai * HALF + m * 16]; bf16_t* rowp = base + (size_t)row * 1024 + col0;
#pragma unroll
                for (int bj = 0; bj < 2; ++bj) { f32x4 v0 = acc[ai][bj][m][0] * rs, v1 = acc[ai][bj][m][1] * rs;
                    if (ACT == 1) { f32x2 a = gelu_pk((f32x2){v0[0], v0[1]}), b = gelu_pk((f32x2){v0[2], v0[3]}), c = gelu_pk((f32x2){v1[0], v1[1]}), d = gelu_pk((f32x2){v1[2], v1[3]});
                        v0 = (f32x4){a.x, a.y, b.x, b.y}; v1 = (f32x4){c.x, c.y, d.x, d.y}; }
                    if (ACT == 2) {
#pragma unroll
                        for (int j = 0; j < 4; ++j) { v0[j] = sigmoid_f(v0[j]); v1[j] = sigmoid_f(v1[j]); } }
                    u32x4 w; w.x = cvt_pk_bf16(v0[0], v0[1]); w.y = cvt_pk_bf16(v0[2], v0[3]); w.z = cvt_pk_bf16(v1[0], v1[1]); w.w = cvt_pk_bf16(v1[2], v1[3]);
                    *(u32x4*)(rowp + bj * HALF) = w; } }
    }
    __device__ __forceinline__ void operator()(const f32x4 (&acc)[2][2][4][2], const Unit& u, int wr, int wc, int fr, int fq, const PG8_LAS float* rl) const {
        rl += wr * 64 + fr;
        const int t = (u.pn * BM) >> 10, colt = u.pn * BM - (t << 10);
        bf16_t* base = O + (size_t)t * stride; const int a = mode == 0 ? (t < 2 ? 1 : 2) : (t == 3 ? 2 : 0);
        const int row0 = u.pm * BM + wr * 64 + fr, col0 = colt + wc * 32 + 8 * fq;
        if (a == 0) body<0>(acc, base, row0, col0, rl); else if (a == 1) body<1>(acc, base, row0, col0, rl); else body<2>(acc, base, row0, col0, rl);
        if (mode == 1 && (t == 0 || t == 2)) {
            float mx[2] = {0.f, 0.f};
#pragma unroll
            for (int ai = 0; ai < 2; ++ai)
#pragma unroll
                for (int m = 0; m < 4; ++m) { const float rs = rl[ai * HALF + m * 16];
#pragma unroll
                    for (int bj = 0; bj < 2; ++bj) { const f32x4 v0 = acc[ai][bj][m][0] * rs, v1 = acc[ai][bj][m][1] * rs;
                        float s = (v0[0] * v0[0] + v0[1] * v0[1]) + (v0[2] * v0[2] + v0[3] * v0[3]) + (v1[0] * v1[0] + v1[1] * v1[1]) + (v1[2] * v1[2] + v1[3] * v1[3]);
                        s += __int_as_float(__builtin_amdgcn_ds_swizzle(__float_as_int(s), (16 << 10) | 0x1f));
                        { auto rr = __builtin_amdgcn_permlane32_swap(__float_as_uint(s), __float_as_uint(s), false, false); s = __uint_as_float(rr[0]) + __uint_as_float(rr[1]); }
                        mx[bj] = fmaxf(mx[bj], s); } }
#pragma unroll
            for (int bj = 0; bj < 2; ++bj) { float v = mx[bj];
                v = fmaxf(v, __int_as_float(__builtin_amdgcn_ds_swizzle(__float_as_int(v), (1 << 10) | 0x1f))); v = fmaxf(v, __int_as_float(__builtin_amdgcn_ds_swizzle(__float_as_int(v), (2 << 10) | 0x1f)));
                v = fmaxf(v, __int_as_float(__builtin_amdgcn_ds_swizzle(__float_as_int(v), (4 << 10) | 0x1f))); v = fmaxf(v, __int_as_float(__builtin_amdgcn_ds_swizzle(__float_as_int(v), (8 << 10) | 0x1f)));
                mx[bj] = v; }
            if (fr == 0 && fq == 0) { const int b = u.pm >> 5;
#pragma unroll
                for (int bj = 0; bj < 2; ++bj) { const int bh = b * 8 + (u.pn & 3) * 2 + bj; atomicMax(nrm + ((bh * 2 + (t == 0 ? 1 : 0)) * 4 + wc), __float_as_uint(mx[bj])); } }
        }
    }
};
template <class Epi, class Sched, bool ALIGN_EPI = false, bool SP2 = false>
__device__ __forceinline__ void gemm_phase(PG8_LAS unsigned char* lds, const Gemm g, const Sched& S, const Epi& E, int wave_s) {
    int tid = 0; asm volatile("" : "+v"(tid)); tid = wave_s * 64 + (int)__builtin_amdgcn_mbcnt_hi(~0u, __builtin_amdgcn_mbcnt_lo(~0u, (unsigned)tid)); asm volatile("" : "+v"(tid));
    const int wid = __builtin_amdgcn_readfirstlane(tid >> 6), lane = tid & 63, wr = wid >> 2, wc = wid & 3, fr = lane & 15, fq = lane >> 4;
    const int K = g.K, nt = K / BK;
    unsigned voffA[2], voffB[2];
#pragma unroll
    for (int i = 0; i < 2; ++i) { int R, C; stage_rc(tid * 16 + i * 8192, R, C); const int Rb = Epi::PERM ? ((R & ~31) + perm32(R & 31)) : R;
        voffA[i] = (unsigned)(R * K + C) * 2u; voffB[i] = (unsigned)(Rb * K + C) * 2u; }
    const size_t kstep = (size_t)(BK * 2);
    const size_t hstep = (size_t)HALF * K * 2;
    const size_t tstep = 2 * hstep;
    const unsigned ldsw = (unsigned)wid * 1024u;
    const int aoff = lds_byte(wr * 64 + fr, fq * 8), boff = lds_byte(wc * 32 + fr, fq * 8);
#define PG8_SA(b, h) (((b) * 2 + (h)) * HTB)
#define PG8_SB(b, h) ((4 + (b) * 2 + (h)) * HTB)
#define PG8_STAGE(bufoff, gbase, voff) do { _Pragma("unroll") for (int _i = 0; _i < 2; ++_i) \
        __builtin_amdgcn_global_load_lds((const unsigned*)((const char*)(gbase) + (voff)[_i]), (PG8_LAS unsigned*)(lds + (bufoff) + ldsw + _i * 8192), 16, 0, 0); } while (0)
#define PG8_LDA(dst, b, h) do { _Pragma("unroll") for (int m = 0; m < 4; ++m) _Pragma("unroll") for (int k = 0; k < 2; ++k) dst[m][k] = *(const PG8_LAS bf16x8*)(lds + PG8_SA(b, h) + aoff + m * 2048 + k * 1024); } while (0)
#define PG8_LDB(dst, b, h) do { _Pragma("unroll") for (int n = 0; n < 2; ++n) _Pragma("unroll") for (int k = 0; k < 2; ++k) dst[n][k] = *(const PG8_LAS bf16x8*)(lds + PG8_SB(b, h) + boff + n * 2048 + k * 1024); } while (0)
#define PG8_MMA(ai, bj, At, Bt) do { __builtin_amdgcn_s_setprio(1); _Pragma("unroll") for (int m = 0; m < 4; ++m) _Pragma("unroll") for (int n = 0; n < 2; ++n) _Pragma("unroll") for (int k = 0; k < 2; ++k) \
        acc[ai][bj][m][n] = __builtin_amdgcn_mfma_f32_16x16x32_bf16(Bt[n][k], At[m][k], acc[ai][bj][m][n], 0, 0, 0); __builtin_amdgcn_s_setprio(0); } while (0)
#define PG8_WAIT_V(n) asm volatile("s_waitcnt vmcnt(" #n ")" ::: "memory")
#define PG8_WAIT_L(n) asm volatile("s_waitcnt lgkmcnt(" #n ")" ::: "memory")
#define PG8_BAR __builtin_amdgcn_s_barrier()
#define PG8_SCHED __builtin_amdgcn_sched_barrier(0)
    Unit cur, nxt; int ui = 0;
    if (!S.next(0, cur)) return;
    f32x4 acc[2][2][4][2];
#pragma unroll
    for (int a = 0; a < 2; ++a)
#pragma unroll
        for (int b = 0; b < 2; ++b)
#pragma unroll
            for (int m = 0; m < 4; ++m)
#pragma unroll
                for (int n = 0; n < 2; ++n) acc[a][b][m][n] = (f32x4){0.f, 0.f, 0.f, 0.f};
    bf16x8 At[4][2], B0[2][2], B1[2][2];
    const char* cA = (const char*)g.A + (size_t)cur.pm * tstep; const char* cB = (const char*)g.Bt + (size_t)cur.pn * tstep;
    S.a_ready(cur);
    if constexpr (Epi::RSTD_LDS) { if (wid < 4) __builtin_amdgcn_global_load_lds((const unsigned*)(E.rstd + cur.pm * BM + wid * 64 + lane), (PG8_LAS unsigned*)(lds + STAGE_BYTES + wid * 256), 4, 0, 0); }
    if constexpr (SP2) {
        PG8_STAGE(PG8_SB(0, 0), cB, voffB); PG8_STAGE(PG8_SB(0, 1), cB + hstep, voffB); PG8_STAGE(PG8_SA(0, 0), cA, voffA); PG8_STAGE(PG8_SA(0, 1), cA + hstep, voffA);
        if (wr == 1) PG8_BAR;
        PG8_WAIT_V(2); PG8_BAR;
        PG8_STAGE(PG8_SB(1, 0), cB + kstep, voffB); PG8_STAGE(PG8_SA(1, 0), cA + kstep, voffA); PG8_STAGE(PG8_SB(1, 1), cB + hstep + kstep, voffB);
        PG8_WAIT_V(6); PG8_BAR;
    } else {
        PG8_STAGE(PG8_SB(0, 0), cB, voffB); PG8_STAGE(PG8_SA(0, 0), cA, voffA); PG8_STAGE(PG8_SB(0, 1), cB + hstep, voffB); PG8_STAGE(PG8_SA(0, 1), cA + hstep, voffA);
        if (wr == 1) PG8_BAR;
        PG8_WAIT_V(4); PG8_BAR;
        PG8_STAGE(PG8_SB(1, 0), cB + kstep, voffB); PG8_STAGE(PG8_SA(1, 0), cA + kstep, voffA); PG8_STAGE(PG8_SB(1, 1), cB + hstep + kstep, voffB);
        PG8_WAIT_V(6); PG8_BAR;
    }
    for (;;) {
        const bool has_next = S.next(ui + 1, nxt);
        const char* nA = has_next ? (const char*)g.A + (size_t)nxt.pm * tstep : cA; const char* nB = has_next ? (const char*)g.Bt + (size_t)nxt.pn * tstep : cB;
        for (int t = 0; t < nt; t += 2) {
            const bool last = (t == nt - 2);
            const char* a1 = cA + (size_t)(t + 1) * kstep;
            const char* a2 = last ? nA : cA + (size_t)(t + 2) * kstep; const char* b2 = last ? nB : cB + (size_t)(t + 2) * kstep;
            const char* a3 = a2 + kstep; const char* b3 = b2 + kstep;
            if (last && has_next) S.a_ready(nxt);
            if constexpr (Epi::RSTD_LDS) { if (last && has_next && wid < 4) __builtin_amdgcn_global_load_lds((const unsigned*)(E.rstd + nxt.pm * BM + wid * 64 + lane), (PG8_LAS unsigned*)(lds + STAGE_BYTES + ((ui + 1) & 1) * 1024 + wid * 256), 4, 0, 0); }
            if constexpr (SP2) {
            PG8_LDB(B0, 0, 0); PG8_LDB(B1, 0, 1); PG8_SCHED; PG8_LDA(At, 0, 0); PG8_STAGE(PG8_SA(1, 1), a1 + hstep, voffA);
            PG8_WAIT_V(8); PG8_WAIT_L(0); PG8_BAR; PG8_MMA(0, 0, At, B0); PG8_MMA(0, 1, At, B1); PG8_BAR; PG8_SCHED;
            PG8_LDA(At, 0, 1); PG8_STAGE(PG8_SB(0, 0), b2, voffB); PG8_STAGE(PG8_SB(0, 1), b2 + hstep, voffB); PG8_STAGE(PG8_SA(0, 0), a2, voffA);
            PG8_WAIT_V(8); PG8_WAIT_L(0); PG8_BAR; PG8_MMA(1, 0, At, B0); PG8_MMA(1, 1, At, B1); PG8_BAR; PG8_SCHED;
            PG8_LDB(B0, 1, 0); PG8_LDB(B1, 1, 1); PG8_SCHED; PG8_LDA(At, 1, 0); PG8_STAGE(PG8_SA(0, 1), a2 + hstep, voffA);
            PG8_WAIT_V(8); PG8_WAIT_L(0); PG8_BAR; PG8_MMA(0, 0, At, B0); PG8_MMA(0, 1, At, B1); PG8_BAR; PG8_SCHED;
            PG8_LDA(At, 1, 1); PG8_STAGE(PG8_SB(1, 0), b3, voffB); PG8_STAGE(PG8_SB(1, 1), b3 + hstep, voffB); PG8_STAGE(PG8_SA(1, 0), a3, voffA);
            PG8_WAIT_V(8); PG8_WAIT_L(0); PG8_BAR; PG8_MMA(1, 0, At, B0); PG8_MMA(1, 1, At, B1); PG8_BAR; PG8_SCHED;
            } else {
            PG8_LDB(B0, 0, 0); PG8_SCHED; PG8_LDA(At, 0, 0); PG8_STAGE(PG8_SA(1, 1), a1 + hstep, voffA);
            PG8_WAIT_L(8); PG8_BAR; PG8_WAIT_L(0); PG8_MMA(0, 0, At, B0); PG8_BAR; PG8_SCHED;
            PG8_LDB(B1, 0, 1); PG8_STAGE(PG8_SB(0, 0), b2, voffB);
            PG8_BAR; PG8_WAIT_L(0); PG8_MMA(0, 1, At, B1); PG8_BAR;
            PG8_LDA(At, 0, 1); PG8_STAGE(PG8_SA(0, 0), a2, voffA);
            PG8_BAR; PG8_WAIT_L(0); PG8_MMA(1, 0, At, B0); PG8_BAR; PG8_SCHED;
            PG8_STAGE(PG8_SB(0, 1), b2 + hstep, voffB);
            PG8_WAIT_V(6); PG8_BAR; PG8_MMA(1, 1, At, B1); PG8_BAR;
            PG8_LDB(B0, 1, 0); PG8_SCHED; PG8_LDA(At, 1, 0); PG8_STAGE(PG8_SA(0, 1), a2 + hstep, voffA);
            PG8_WAIT_L(8); PG8_BAR; PG8_WAIT_L(0); PG8_MMA(0, 0, At, B0); PG8_BAR; PG8_SCHED;
            PG8_LDB(B1, 1, 1); PG8_STAGE(PG8_SB(1, 0), b3, voffB);
            PG8_BAR; PG8_WAIT_L(0); PG8_MMA(0, 1, At, B1); PG8_BAR;
            PG8_LDA(At, 1, 1); PG8_STAGE(PG8_SA(1, 0), a3, voffA);
            PG8_BAR; PG8_WAIT_L(0); PG8_MMA(1, 0, At, B0); PG8_BAR; PG8_SCHED;
            PG8_STAGE(PG8_SB(1, 1), b3 + hstep, voffB);
            PG8_WAIT_V(6); PG8_BAR; PG8_MMA(1, 1, At, B1); PG8_BAR;
            }
        }
        if constexpr (ALIGN_EPI) { if (wr == 0) PG8_BAR; }
        if constexpr (!Epi::AFTER_DRAIN) { if constexpr (Epi::RSTD_LDS) E(acc, cur, wr, wc, fr, fq, (const PG8_LAS float*)(lds + STAGE_BYTES + (ui & 1) * 1024)); else E(acc, cur, wr, wc, fr, fq); S.done(cur); }
        if (!has_next) break;
#pragma unroll
        for (int a = 0; a < 2; ++a)
#pragma unroll
            for (int b = 0; b < 2; ++b)
#pragma unroll
                for (int m = 0; m < 4; ++m)
#pragma unroll
                    for (int n = 0; n < 2; ++n) acc[a][b][m][n] = (f32x4){0.f, 0.f, 0.f, 0.f};
        cur = nxt; cA = nA; cB = nB; ++ui;
        if constexpr (ALIGN_EPI) { if (wr == 1) PG8_BAR; }
    }
    PG8_WAIT_V(0);
    if constexpr (!ALIGN_EPI) { if (wr == 0) PG8_BAR; }
    PG8_BAR;
    if constexpr (Epi::AFTER_DRAIN) { E.fused(acc, cur, wr, wc, fr, fq, lds, wid, lane); S.done(cur); }
#undef PG8_SA
#undef PG8_SB
#undef PG8_STAGE
#undef PG8_LDA
#undef PG8_LDB
#undef PG8_MMA
#undef PG8_WAIT_V
#undef PG8_WAIT_L
#undef PG8_BAR
#undef PG8_SCHED
}
}

namespace att {
#define ALAS __attribute__((address_space(3)))
constexpr int D = 128, RS = 1024;
constexpr float SCALE = 0.08838834764831845f;
constexpr float THR = 8.f;
constexpr bool WSKIP = false;
constexpr int NW = 8, QBLK = 32, KVBLK = 64, QB = NW * QBLK;
constexpr int SHM_V = KVBLK * D * 2, SHM_K = KVBLK * D * 2;
constexpr int LDS_CORE = 2 * SHM_V + 2 * SHM_K + NW * 64 * 4;
constexpr int KB_OFF = LDS_CORE;
constexpr int LDS_BYTES = KB_OFF + 8192 * 4;
using bf16 = __hip_bfloat16;
typedef short bf16x8 __attribute__((ext_vector_type(8)));
typedef short s16x4 __attribute__((ext_vector_type(4)));
typedef float f32x16 __attribute__((ext_vector_type(16)));
typedef float f32x4 __attribute__((ext_vector_type(4)));
typedef unsigned u32x4 __attribute__((ext_vector_type(4)));
template <class A, class Bt> struct same_t { static constexpr bool v = false; };
template <class A> struct same_t<A, A> { static constexpr bool v = true; };

#define KSWZ(row, colB) ((row) * 256 + ((colB) ^ (((row) & 7) << 4)))
#define SBAR() __builtin_amdgcn_sched_barrier(0)
__device__ __forceinline__ int v_st(int k, int c) { const int kk = (k & ~0xC) | ((k & 4) << 1) | ((k & 8) >> 1); return ((kk >> 3) * 4 + (c >> 5)) * 512 + ((kk & 7) * 32 + (c & 31)) * 2; }
__device__ __forceinline__ int v_rd_base(int lane) { return ((lane & 3) << 3) | (((lane >> 2) & 3) << 6) | (((lane >> 4) & 1) << 5) | (((lane >> 5) & 1) << 8); }
constexpr int v_rd_off(int d0, int ks, int half) { return d0 * 512 + ks * 4096 + half * 2048; }
__device__ __forceinline__ int crow(int r, int hi) { return (r & 3) + 8 * (r >> 2) + 4 * hi; }
__device__ __forceinline__ unsigned cvtpk(float lo, float hi) {
    typedef float f32x2_t __attribute__((ext_vector_type(2))); typedef __bf16 bf16x2_t __attribute__((ext_vector_type(2)));
    f32x2_t v = {lo, hi}; bf16x2_t b = __builtin_convertvector(v, bf16x2_t); return __builtin_bit_cast(unsigned, b);
}
__device__ __forceinline__ bf16x8 pack8(f32x4 a, f32x4 b) {
    u32x4 w = {cvtpk(a[0], a[1]), cvtpk(a[2], a[3]), cvtpk(b[0], b[1]), cvtpk(b[2], b[3])};
    return *reinterpret_cast<bf16x8*>(&w);
}
template <class T> __device__ __forceinline__ bf16x8 load8(const T* p) {
    if constexpr (same_t<T, float>::v) { return pack8(*(const f32x4*)p, *(const f32x4*)(p + 4)); }
    else { return *reinterpret_cast<const bf16x8*>(p); }
}
__device__ __forceinline__ void mask_tile(f32x16& p0, f32x16& p1, int dq, unsigned W) {
    const float NEG = -__builtin_inff();
#pragma unroll
    for (int r = 0; r < 16; ++r) {
        const int c = (r & 3) + 8 * (r >> 2);
        if ((unsigned)(dq - c) >= W) p0[r] = NEG;
        if ((unsigned)(dq - c - 32) >= W) p1[r] = NEG;
    }
}
__device__ __forceinline__ void partialSM(f32x16& p0, f32x16& p1, float& m_reg, float& mn, float& alpha) {
    float pmax = p0[0]; for (int r = 1; r < 16; ++r) pmax = fmaxf(pmax, p0[r]); for (int r = 0; r < 16; ++r) pmax = fmaxf(pmax, p1[r]);
    { auto rr = __builtin_amdgcn_permlane32_swap(__float_as_uint(pmax), __float_as_uint(pmax), false, false);
      pmax = fmaxf(__uint_as_float(rr[0]), __uint_as_float(rr[1])); }
    constexpr float C2 = 1.4426950408889634f * SCALE;
    if (__builtin_expect(__all((pmax - m_reg) * SCALE <= THR), 1)) { mn = m_reg; alpha = 1.f; }
    else { mn = fmaxf(m_reg, pmax); alpha = __builtin_amdgcn_exp2f((m_reg - mn) * C2); m_reg = mn; }
    const float mnL = -mn * C2;
    for (int r = 0; r < 16; ++r) p0[r] = fmaf(p0[r], C2, mnL); for (int r = 0; r < 16; ++r) p1[r] = fmaf(p1[r], C2, mnL);
    for (int r = 0; r < 16; ++r) p0[r] = __builtin_amdgcn_exp2f(p0[r]);
}
__device__ __forceinline__ void finishSM(f32x16& p0, f32x16& p1, float alpha, float& l_reg, bf16x8& pa0, bf16x8& pa1, bf16x8& pa2, bf16x8& pa3) {
    for (int r = 0; r < 16; ++r) p1[r] = __builtin_amdgcn_exp2f(p1[r]);
    float ps = 0; for (int r = 0; r < 16; ++r) ps += p0[r]; for (int r = 0; r < 16; ++r) ps += p1[r];
    { auto rr = __builtin_amdgcn_permlane32_swap(__float_as_uint(ps), __float_as_uint(ps), false, false);
      ps = __uint_as_float(rr[0]) + __uint_as_float(rr[1]); }
    l_reg = l_reg * alpha + ps;
#define PK4(P, B_, OUT) do { unsigned a0 = cvtpk(P[B_+0], P[B_+1]), a1 = cvtpk(P[B_+2], P[B_+3]);                          \
        unsigned b0 = cvtpk(P[B_+4], P[B_+5]), b1 = cvtpk(P[B_+6], P[B_+7]);                                             \
        auto r0 = __builtin_amdgcn_permlane32_swap(a0, b0, false, false); auto r1 = __builtin_amdgcn_permlane32_swap(a1, b1, false, false); \
        u32x4 w = {r0[0], r1[0], r0[1], r1[1]}; OUT = *reinterpret_cast<bf16x8*>(&w); } while (0)
    PK4(p0, 0, pa0); PK4(p0, 8, pa1); PK4(p1, 0, pa2); PK4(p1, 8, pa3);
#undef PK4
}
template <int KB>
__device__ __forceinline__ void qkt(f32x16& p0, f32x16& p1, const char* K_lds, int r32, int hi, const bf16x8* qr, const ALAS float* kbt) {
#pragma unroll
    for (int g = 0; g < 4; ++g) { const f32x4 a = *(const ALAS f32x4*)(kbt + 8 * g), b = *(const ALAS f32x4*)(kbt + 32 + 8 * g);
        p0[4 * g] = a[0]; p0[4 * g + 1] = a[1]; p0[4 * g + 2] = a[2]; p0[4 * g + 3] = a[3];
        p1[4 * g] = b[0]; p1[4 * g + 1] = b[1]; p1[4 * g + 2] = b[2]; p1[4 * g + 3] = b[3]; }
    const char* kb[4];
#pragma unroll
    for (int dd = 0; dd < 4; ++dd) kb[dd] = K_lds + KB * SHM_K + KSWZ(r32, (dd * 16 + hi * 8) * 2);
#pragma unroll
    for (int d0 = 0; d0 < 8; ++d0) { const char* a = kb[d0 & 3] + (d0 >> 2) * 128;
        bf16x8 b0 = *reinterpret_cast<const bf16x8*>(a);
        bf16x8 b1 = *reinterpret_cast<const bf16x8*>(a + 32 * 256);
        p0 = __builtin_amdgcn_mfma_f32_32x32x16_bf16(b0, qr[d0], p0, 0, 0, 0);
        p1 = __builtin_amdgcn_mfma_f32_32x32x16_bf16(b1, qr[d0], p1, 0, 0, 0); }
}
template <int VB, bool SK>
__device__ __forceinline__ void pv_tile(f32x16* o, int vb0, bf16x8 pa0, bf16x8 pa1, bf16x8 pa2, bf16x8 pa3, bool act) {
    if (SK && !act) return;
#define TRRD(dst, off) asm volatile("ds_read_b64_tr_b16 %0, %1 offset:%2" : "=&v"(dst) : "v"(vb0), "i"(off) : "memory")
#define PV_D0(d0) do { s16x4 l0, l1, l2, l3, h0, h1, h2, h3; constexpr int b_ = VB * SHM_V + v_rd_off(d0, 0, 0);     \
        TRRD(l0, b_); TRRD(h0, b_ + 2048); TRRD(l1, b_ + 4096); TRRD(h1, b_ + 6144); TRRD(l2, b_ + 8192); TRRD(h2, b_ + 10240); TRRD(l3, b_ + 12288); TRRD(h3, b_ + 14336); \
        asm volatile("s_waitcnt lgkmcnt(0)" ::: "memory"); SBAR();                 \
        o[d0] = __builtin_amdgcn_mfma_f32_32x32x16_bf16(pa0, (bf16x8){l0[0], l0[1], l0[2], l0[3], h0[0], h0[1], h0[2], h0[3]}, o[d0], 0, 0, 0);   \
        o[d0] = __builtin_amdgcn_mfma_f32_32x32x16_bf16(pa1, (bf16x8){l1[0], l1[1], l1[2], l1[3], h1[0], h1[1], h1[2], h1[3]}, o[d0], 0, 0, 0);   \
        o[d0] = __builtin_amdgcn_mfma_f32_32x32x16_bf16(pa2, (bf16x8){l2[0], l2[1], l2[2], l2[3], h2[0], h2[1], h2[2], h2[3]}, o[d0], 0, 0, 0);   \
        o[d0] = __builtin_amdgcn_mfma_f32_32x32x16_bf16(pa3, (bf16x8){l3[0], l3[1], l3[2], l3[3], h3[0], h3[1], h3[2], h3[3]}, o[d0], 0, 0, 0); } while (0)
    PV_D0(0); PV_D0(1); PV_D0(2); PV_D0(3);
#undef PV_D0
#undef TRRD
}

struct BlockRef { const bf16* Q; const bf16* K; const bf16* V; bf16* O; const bf16* GA; const bf16* OB; int P0; int jlo; int bh; };
struct Seam { bf16x8 qr[8]; bf16x8 st_v0, st_v1, st_k0, st_k1; };
#define VMW() asm volatile("s_waitcnt vmcnt(0)" ::: "memory")
#define VMWN(n) asm volatile("s_waitcnt vmcnt(%0)" :: "i"(n) : "memory")
#define SLOAD_H(Kp, Vp, k0) do { const bf16* kt_ = (Kp) + (size_t)(k0) * RS; const bf16* vt_ = (Vp) + (size_t)(k0) * RS;                      \
                         S.st_v0 = load8<bf16>(vt_ + kvo0); S.st_v1 = load8<bf16>(vt_ + kvo1);                                       \
                         S.st_k0 = load8<bf16>(kt_ + kvo0); S.st_k1 = load8<bf16>(kt_ + kvo1); } while (0)
#define SWRITE_HK(bf) do { *(bf16x8*)(K_lds + (bf) * SHM_K + kws) = S.st_k0; *(bf16x8*)(K_lds + (bf) * SHM_K + kws + 32 * 256) = S.st_k1; } while (0)
#define SWRITE_HV(bf) do { *(bf16x8*)(V_lds + (bf) * SHM_V + vst0) = S.st_v0; *(bf16x8*)(V_lds + (bf) * SHM_V + vst1) = S.st_v1; } while (0)
#define SWRITE_H(bf) do { SWRITE_HV(bf); SWRITE_HK(bf); } while (0)
__device__ __forceinline__ void fox_prime(const BlockRef& cur, char* lds, Seam& S, int wave_s) {
    int tid = 0; asm volatile("" : "+v"(tid)); tid = wave_s * 64 + (int)__builtin_amdgcn_mbcnt_hi(~0u, __builtin_amdgcn_mbcnt_lo(~0u, (unsigned)tid)); asm volatile("" : "+v"(tid));
    const int wid = __builtin_amdgcn_readfirstlane(tid >> 6), lane = tid & 63, r32 = lane & 31, hi = lane >> 5;
    const int sr = tid >> 4, sc = (tid & 15) * 8, kws = KSWZ(sr, sc * 2); char* K_lds = lds + 2 * SHM_V;
    const unsigned kvo0 = (unsigned)(sr * RS + sc), kvo1 = kvo0 + 32u * RS, qo = (unsigned)(r32 * RS + hi * 8);
    { const bf16* qb_ = cur.Q + (size_t)(wid * QBLK) * RS;
#pragma unroll
    for (int d0 = 0; d0 < 8; ++d0) S.qr[d0] = load8<bf16>(qb_ + qo + d0 * 16); }
    SLOAD_H(cur.K, cur.V, cur.jlo * KVBLK); VMW(); SWRITE_HK(0);
    __syncthreads();
}
constexpr int CW_QCTR = 3584, CW_NRM = 3616;
constexpr float FOX_L = 40.0f;
struct FoxCtx { unsigned short* Qb; const unsigned short* Kb; const unsigned short* Vb; const unsigned short* GAb; const unsigned short* OBb; const float* kbias; unsigned* ctl; volatile ALAS unsigned* slot; };
__device__ __forceinline__ BlockRef fox_mkref(int n, const FoxCtx& cx, int lane) {
    unsigned short* Qb = cx.Qb; const unsigned short* Kb = cx.Kb; const unsigned short* Vb = cx.Vb; const unsigned short* GAb = cx.GAb; const unsigned short* OBb = cx.OBb; const float* kbias = cx.kbias; const unsigned* ctl = cx.ctl;
    const int bh = n & 31, qb = 31 - (n >> 5), b = bh >> 3, h = bh & 7;
    const size_t qo = ((size_t)b * 8192 + (size_t)qb * 256) * RS + h * 128, ko = (size_t)b * 8192 * RS + h * 128;
    BlockRef r; r.Q = (const bf16*)(Qb + qo); r.O = (bf16*)(Qb + qo); r.K = (const bf16*)(Kb + ko); r.V = (const bf16*)(Vb + ko);
    r.GA = (const bf16*)(GAb + qo); r.OB = (const bf16*)(OBb + qo); r.P0 = qb * 256; r.bh = bh;
    const float* kbg = kbias + (size_t)bh * 8192; const int nt0 = r.P0 >> 6;
    const float kb0 = kbg[r.P0], ka = kbg[64 * lane + 63], kb_ = kbg[64 * (lane + 64) + 63];
    f32x4 qv_, kv_;
    { const unsigned* np_ = ctl + CW_NRM + bh * 8;
      asm volatile("global_load_dwordx4 %0, %2, off sc0 sc1\n\tglobal_load_dwordx4 %1, %2, off offset:16 sc0 sc1\n\ts_waitcnt vmcnt(0)" : "=&v"(qv_), "=&v"(kv_) : "v"(np_) : "memory"); }
    const float qn2 = (qv_.x + qv_.y) + (qv_.z + qv_.w), kn2 = (kv_.x + kv_.y) + (kv_.z + kv_.w);
    const float thr = FOX_L * 11.313708498984761f + 2.05f * sqrtf(qn2 * kn2);
    const int cnt = __popcll(__ballot(lane < nt0 && (kb0 - ka) > thr)) + __popcll(__ballot(lane + 64 < nt0 && (kb0 - kb_) > thr));
    r.jlo = __builtin_amdgcn_readfirstlane(cnt);
    return r;
}
__device__ __forceinline__ unsigned fox_fetch(unsigned* ctl) { return __hip_atomic_fetch_add(ctl + CW_QCTR, 1u, __ATOMIC_RELAXED, __HIP_MEMORY_SCOPE_AGENT); }
__device__ __forceinline__ void fox_block(const BlockRef& cur, BlockRef& nxt, bool& last, const FoxCtx& cx, char* lds, const ALAS float* kbl, Seam& S, int wave_s) {
    int tid = 0; asm volatile("" : "+v"(tid)); tid = wave_s * 64 + (int)__builtin_amdgcn_mbcnt_hi(~0u, __builtin_amdgcn_mbcnt_lo(~0u, (unsigned)tid)); asm volatile("" : "+v"(tid));
    const int wid = __builtin_amdgcn_readfirstlane(tid >> 6), lane = tid & 63, r32 = lane & 31, hi = lane >> 5;
    constexpr int W = 1 << 30; constexpr bool SK = false;
    const int j_lo = cur.jlo, NT = (cur.P0 + QB - 1) / KVBLK + 1 - j_lo;
    const int qlo = cur.P0 + wid * QBLK, qm = qlo + r32 - 4 * hi;
    char* V_lds = lds; char* K_lds = lds + 2 * SHM_V;
    float* ws = (float*)(lds + 2 * SHM_V + 2 * SHM_K) + wid * 64; float* li_l = ws, * al_l = ws + 32;
    float m_reg = -1e30f, l_reg = 0; f32x16 o[4] = {};
    const int sr = tid >> 4, sc = (tid & 15) * 8, vst0 = v_st(sr, sc), vst1 = v_st(32 + sr, sc), kws = KSWZ(sr, sc * 2);
    const int vb0 = (int)(uintptr_t)V_lds + v_rd_base(lane);
    const unsigned kvo0 = (unsigned)(sr * RS + sc), kvo1 = kvo0 + 32u * RS, qo = (unsigned)(r32 * RS + hi * 8);
    const bf16* Kh = cur.K; const bf16* Vh = cur.V;
    const ALAS float* kbh = kbl + 4 * hi;
#define RESC(a) do { if (__any((a) < 1.f)) { if (hi == 0) al_l[r32] = (a); asm volatile("s_waitcnt lgkmcnt(0)" ::: "memory");              \
                     for (int d_ = 0; d_ < 4; ++d_) for (int r = 0; r < 16; ++r) o[d_][r] *= al_l[crow(r, hi)]; } } while (0)
#define KBASE(t) ((j_lo + (t)) * KVBLK)
#define MASKT(P0_, P1_, t) do { const int kb_ = KBASE(t); if (kb_ + KVBLK - 1 > qlo) mask_tile(P0_, P1_, qm - kb_, (unsigned)W); } while (0)
    constexpr int NQL = 8;
#define SEAM_K0() do { VMWN(NQL); SWRITE_HK(0); SBAR(); } while (0)
    f32x16 pA0, pA1, pB0, pB1; float mnA, mnB, alA, alB; bf16x8 pa0, pa1, pa2, pa3;
    SWRITE_HV(0); SBAR();
    if (NT > 1) { SLOAD_H(Kh, Vh, KBASE(1)); }
    SBAR(); qkt<0>(pA0, pA1, K_lds, r32, hi, S.qr, kbh + KBASE(0));
    MASKT(pA0, pA1, 0); partialSM(pA0, pA1, m_reg, mnA, alA);
    if (NT > 1) { VMW(); SWRITE_H(1); }
    __syncthreads();
#define HALF_STEP(PX0, PX1, mnX, alX, PY0, PY1, alY, t, KB, VB, SB) do {                                                      \
        SBAR(); qkt<KB>(PX0, PX1, K_lds, r32, hi, S.qr, kbh + KBASE(t));                                                      \
        finishSM(PY0, PY1, alY, l_reg, pa0, pa1, pa2, pa3); SBAR();                                                           \
        if ((t) + 1 < NT) { SLOAD_H(Kh, Vh, KBASE((t) + 1)); SBAR(); }                                                        \
        pv_tile<VB, SK>(o, vb0, pa0, pa1, pa2, pa3, true); MASKT(PX0, PX1, (t)); partialSM(PX0, PX1, m_reg, mnX, alX);         \
        __syncthreads();                                                                                                      \
        if ((t) + 1 < NT) { VMW(); SWRITE_H(SB); }                                                                            \
        RESC(alX); __syncthreads(); } while (0)
    const int tf = NT >= 8 ? ((NT - 5) | 1) : -1;
    if (tf < 0 && tid == 0) cx.slot[0] = fox_fetch(cx.ctl);
    for (int t = 1; t + 1 < NT; t += 2) {
        if (t == tf && tid == 0) cx.slot[0] = fox_fetch(cx.ctl);
        HALF_STEP(pB0, pB1, mnB, alB, pA0, pA1, alA, t, 1, 0, 0);
        HALF_STEP(pA0, pA1, mnA, alA, pB0, pB1, alB, t + 1, 0, 1, 1);
    }
    const bool even = (NT & 1) == 0;
    if (even) { SBAR(); qkt<1>(pB0, pB1, K_lds, r32, hi, S.qr, kbh + KBASE(NT - 1)); SBAR(); }
    { const int n_nxt = __builtin_amdgcn_readfirstlane((int)cx.slot[0]);
      last = n_nxt >= 1024; if (last) nxt = cur; else nxt = fox_mkref(n_nxt, cx, lane); }
    SBAR();
    SLOAD_H(nxt.K, nxt.V, nxt.jlo * KVBLK); SBAR();
    { const bf16* qb_ = nxt.Q + (size_t)(wid * QBLK) * RS;
#pragma unroll
    for (int d0 = 0; d0 < 8; ++d0) S.qr[d0] = load8<bf16>(qb_ + qo + d0 * 16); }
    SBAR();
    finishSM(pA0, pA1, alA, l_reg, pa0, pa1, pa2, pa3); SBAR();
    pv_tile<0, SK>(o, vb0, pa0, pa1, pa2, pa3, true);
    if (even) { MASKT(pB0, pB1, NT - 1); partialSM(pB0, pB1, m_reg, mnB, alB); __syncthreads(); RESC(alB);
        finishSM(pB0, pB1, alB, l_reg, pa0, pa1, pa2, pa3); SBAR(); pv_tile<1, SK>(o, vb0, pa0, pa1, pa2, pa3, true); }
    SBAR(); SEAM_K0();
    if (hi == 0) li_l[r32] = l_reg; asm volatile("s_waitcnt lgkmcnt(0)" ::: "memory");
    float rli[16];
#pragma unroll
    for (int r = 0; r < 16; ++r) rli[r] = __builtin_amdgcn_rcpf(li_l[crow(r, hi)]);
    const size_t wofs = (size_t)(wid * QBLK) * RS; const bf16* gab = cur.GA + wofs; const bf16* obb = cur.OB + wofs; bf16* oub = cur.O + wofs;
    const unsigned eo = (unsigned)(hi * 4 * RS + r32);
    unsigned gav[2][2][4], obv[2][2][4];
#define EPI_LOAD(rg_) do { _Pragma("unroll") for (int rr = 0; rr < 2; ++rr) _Pragma("unroll") for (int d0 = 0; d0 < 4; ++d0) { const int r = (rg_) * 2 + rr, co = ((r & 3) + 8 * (r >> 2)) * RS + d0 * 32; \
        gav[(rg_) & 1][rr][d0] = ((const unsigned short*)(gab + co))[eo]; obv[(rg_) & 1][rr][d0] = ((const unsigned short*)(obb + co))[eo]; } } while (0)
    EPI_LOAD(0);
#pragma unroll
    for (int rg = 0; rg < 8; ++rg) {
        if (rg < 7) EPI_LOAD(rg + 1);
        SBAR();
#pragma unroll
        for (int rr = 0; rr < 2; ++rr)
#pragma unroll
            for (int d0 = 0; d0 < 4; ++d0) { const int r = rg * 2 + rr, co = ((r & 3) + 8 * (r >> 2)) * RS + d0 * 32;
                const float v = o[d0][r] * rli[r];
                const float m = __uint_as_float(gav[rg & 1][rr][d0] << 16) * v + __uint_as_float(obv[rg & 1][rr][d0] << 16);
                ((unsigned short*)(oub + co))[eo] = (unsigned short)(cvtpk(m, 0.f) & 0xffffu); }
        SBAR(); }
#undef EPI_LOAD
    __syncthreads();
#undef RESC
#undef KBASE
#undef MASKT
#undef SEAM_K0
#undef HALF_STEP
}
#undef ROW
#undef VMW
#undef VMWN
#undef SLOAD_H
#undef SWRITE_HK
#undef SWRITE_HV
#undef SWRITE_H
#undef SBAR
#undef KSWZ
}

#define LAS __attribute__((address_space(3)))
typedef unsigned short bf16u;
typedef unsigned v4u __attribute__((ext_vector_type(4)));
typedef float v4f __attribute__((ext_vector_type(4)));
typedef short v8s __attribute__((ext_vector_type(8)));
typedef float v16f __attribute__((ext_vector_type(16)));

constexpr int T = 32768, DM = 1024, FF = 4096, SEQ = 8192, NH = 8, INW = 7176;
constexpr float RMS_EPS = 1e-6f, LN_EPS = 1e-5f;
constexpr size_t MiB = 1u << 20;
constexpr size_t WS_RSTD0 = 0, WS_RSTD1 = 128 * 1024, WS_RSTD2 = 256 * 1024, WS_WF = 384 * 1024, WS_WSM = 512 * 1024, WS_LOGF = 1 * MiB, WS_KBIAS = 2 * MiB, WS_BAR = 3 * MiB, BAR_BYTES = 16384;
constexpr size_t WS_WGU1 = 4 * MiB, WS_WD1 = 20 * MiB, WS_WIN = 28 * MiB, WS_WOUT = 42 * MiB, WS_WGU2 = 44 * MiB, WS_WD2 = 60 * MiB;
constexpr size_t WS_R0 = 68 * MiB, WS_S0 = 132 * MiB, WS_S1 = 196 * MiB, WS_S2 = 260 * MiB, WS_S3 = 324 * MiB, WS_S4 = 388 * MiB, WS_END = 452 * MiB;
constexpr int LDS_TOTAL = 140 * 1024, LDS_MISC = 136 * 1024;

__device__ __forceinline__ unsigned f2bf(float f) { unsigned u = __builtin_bit_cast(unsigned, f); return (u + 0x7fffu + ((u >> 16) & 1u)) >> 16; }
__device__ __forceinline__ unsigned pk2(float lo, float hi) { return f2bf(lo) | (f2bf(hi) << 16); }
__device__ __forceinline__ float bflo(unsigned w) { return __uint_as_float(w << 16); }
__device__ __forceinline__ float bfhi(unsigned w) { return __uint_as_float(w & 0xffff0000u); }
template <int X> __device__ __forceinline__ float swz_xor(float v) { return __int_as_float(__builtin_amdgcn_ds_swizzle(__float_as_int(v), (X << 10) | 0x1f)); }
template <int CTRL> __device__ __forceinline__ float dpp_f(float v) { return __int_as_float(__builtin_amdgcn_update_dpp(0, __float_as_int(v), CTRL, 0xf, 0xf, false)); }
__device__ __forceinline__ float wave_sum(float v) {
    v += dpp_f<0xB1>(v); v += dpp_f<0x4E>(v); v += dpp_f<0x141>(v); v += dpp_f<0x140>(v); v += swz_xor<16>(v);
    auto rr = __builtin_amdgcn_permlane32_swap(__float_as_uint(v), __float_as_uint(v), false, false);
    return __uint_as_float(rr[0]) + __uint_as_float(rr[1]);
}

#define CAS __attribute__((address_space(4)))
#define XB_TMO      128
#define XB_XCNT(j)  (256  + 64 * (j))
#define XB_XSUB(j)  (1280 + 64 * (j))
#define XB_XGEN(j)  (2304 + 64 * (j))
#define XB_TOP      3328
#define XB_TOPGEN   3392
#define XCD_BAR_WORDS 3456
#define XB_SPIN_CAP (1u << 18)

__device__ __forceinline__ unsigned xb_ld(unsigned* p)              { return __hip_atomic_load(p, __ATOMIC_RELAXED, __HIP_MEMORY_SCOPE_AGENT); }
__device__ __forceinline__ unsigned xb_add(unsigned* p, unsigned v) { return __hip_atomic_fetch_add(p, v, __ATOMIC_RELAXED, __HIP_MEMORY_SCOPE_AGENT); }
__device__ __forceinline__ unsigned xb_xcc_id() { return (unsigned)__builtin_amdgcn_s_getreg((3 << 11) | 20) & 0xFu; }
#define XB_SPIN(cond, bar) do { unsigned _sp = 0; while (cond) { __builtin_amdgcn_s_sleep(1); \
    if ((++_sp & 255u) == 0u) { if (xb_ld(&(bar)[XB_TMO])) break; if (_sp > XB_SPIN_CAP) { atomicAdd(&(bar)[XB_TMO], 1u); break; } } } } while (0)

__device__ __forceinline__ void xcd_barrier_complete(unsigned* bar, unsigned x, unsigned& nloc, unsigned& nx) {
    const unsigned G = gridDim.x * gridDim.y * gridDim.z;
    unsigned sum, cnt, mine, sp = 0u;
    for (;;) {
        sum = 0u; cnt = 0u; mine = 0u;
#pragma unroll
        for (unsigned j = 0; j < 16; ++j) { const unsigned c = xb_ld(&bar[XB_XCNT(j)]); sum += c; cnt += (c > 0u) ? 1u : 0u; mine = (j == x) ? c : mine; }
        if (sum == G) break;
        __builtin_amdgcn_s_sleep(1);
        if ((++sp & 255u) == 0u) { if (xb_ld(&bar[XB_TMO])) break; if (sp > XB_SPIN_CAP) { atomicAdd(&bar[XB_TMO], 1u); break; } }
    }
    nloc = mine > 0u ? mine : 1u; nx = cnt > 0u ? cnt : 1u;
}
__device__ __forceinline__ void xcd_barrier(unsigned* bar, volatile LAS unsigned* st, bool leader) {
    asm volatile("s_waitcnt vmcnt(0)" ::: "memory");
    __syncthreads();
    if (leader) {
        const unsigned x = xb_xcc_id();
        __builtin_amdgcn_s_waitcnt(0);
        unsigned nloc = st[0], nx = st[1];
        if (nloc == 0u) { xcd_barrier_complete(bar, x, nloc, nx); st[0] = nloc; st[1] = nx; }
        const unsigned old = xb_add(&bar[XB_XSUB(x)], 1u);
        const unsigned gen = old / nloc;
        if (old + 1u == (gen + 1u) * nloc) {
            __builtin_amdgcn_fence(__ATOMIC_RELEASE, "agent");
            asm volatile("s_waitcnt vmcnt(0)" ::: "memory");
            const unsigned og = xb_add(&bar[XB_TOP], 1u);
            const unsigned tg = og / nx;
            if (og + 1u == (tg + 1u) * nx) xb_add(&bar[XB_TOPGEN], 1u);
            else XB_SPIN(xb_ld(&bar[XB_TOPGEN]) == tg, bar);
            __builtin_amdgcn_fence(__ATOMIC_ACQUIRE, "agent");
            xb_add(&bar[XB_XGEN(x)], 1u);
            asm volatile("s_waitcnt vmcnt(0)" ::: "memory");
        } else {
            XB_SPIN(xb_ld(&bar[XB_XGEN(x)]) == gen, bar);
            __builtin_amdgcn_fence(__ATOMIC_ACQUIRE, "agent");
            asm volatile("s_waitcnt vmcnt(0)" ::: "memory");
        }
    }
    __syncthreads();
}

struct Params {
    const float* x; const float* f1_pre_g; const float* f1_wg; const float* f1_wu; const float* f1_wd; const float* f1_post_g;
    const float* mix_pre_g; const float* w_in; const float* b_forget; const float* ln_g; const float* ln_b; const float* w_s; const float* b_s;
    const float* w_out; const float* mix_post_g; const float* f2_pre_g; const float* f2_wg; const float* f2_wu; const float* f2_wd; const float* f2_post_g;
    float* out; unsigned char* ws;
};

__device__ __forceinline__ void tr_item(const float* __restrict__ W, int ldn, int K, int scol, bf16u* WT, int drow, const float* __restrict__ g, LAS float* scr, int k0, int lane) {
    float v[32];
    const float* src = W + (size_t)(k0 + (lane >> 5)) * ldn + scol + (lane & 31);
#pragma unroll
    for (int i = 0; i < 32; ++i) v[i] = src[(size_t)(2 * i) * ldn];
    const int c = lane & 7;
    v4f g0 = (v4f){1.f, 1.f, 1.f, 1.f}, g1 = g0;
    if (g) { g0 = *(const v4f*)(g + k0 + 8 * c); g1 = *(const v4f*)(g + k0 + 8 * c + 4); }
#pragma unroll
    for (int i = 0; i < 32; ++i) scr[(2 * i + (lane >> 5)) * 33 + (lane & 31)] = v[i];
    asm volatile("s_waitcnt lgkmcnt(0)" ::: "memory");
#pragma unroll
    for (int j = 0; j < 4; ++j) { const int n = (lane >> 3) + 8 * j; const LAS float* s = scr + (8 * c) * 33 + n;
        v4u o; o.x = pk2(s[0 * 33] * g0.x, s[1 * 33] * g0.y); o.y = pk2(s[2 * 33] * g0.z, s[3 * 33] * g0.w); o.z = pk2(s[4 * 33] * g1.x, s[5 * 33] * g1.y); o.w = pk2(s[6 * 33] * g1.z, s[7 * 33] * g1.w);
        *(v4u*)(WT + (size_t)(drow + n) * K + k0 + 8 * c) = o; }
    asm volatile("s_waitcnt lgkmcnt(0)" ::: "memory");
}

typedef const CAS Params* PP;
__device__ __forceinline__ int fresh_tid(int wave_s) { int t = 0; asm volatile("" : "+v"(t)); t = wave_s * 64 + (int)__builtin_amdgcn_mbcnt_hi(~0u, __builtin_amdgcn_mbcnt_lo(~0u, (unsigned)t)); asm volatile("" : "+v"(t)); return t;     }
__device__ __forceinline__ void p0_prologue(PP p, LAS unsigned char* lds, int gw, int NGW, int lane, int wave, int gtid, int NGT) {
    unsigned char* ws = p->ws;
    LAS float* scr = (LAS float*)(lds + wave * 16384);
    constexpr int I_G = 16 * 128, I_D = 64 * 32, I_IN = 16 * 224, I_O = 16 * 32;
    constexpr int NITEMS = 2 * (2 * I_G + I_D) + I_IN + I_O;
    for (int it = gw; it < NITEMS; it += NGW) {
        int r = it;
        if (r < 2 * I_G) { const bool up = r >= I_G; if (up) r -= I_G; const int kb = r >> 7, nb = r & 127, n0 = nb * 32;
            tr_item(up ? p->f1_wu : p->f1_wg, FF, DM, n0, (bf16u*)(ws + WS_WGU1), (n0 >> 7) * 256 + (n0 & 127) + (up ? 128 : 0), p->f1_pre_g, scr, kb * 64, lane); continue; }
        r -= 2 * I_G;
        if (r < I_D) { const int kb = r >> 5, nb = r & 31; tr_item(p->f1_wd, DM, FF, nb * 32, (bf16u*)(ws + WS_WD1), nb * 32, nullptr, scr, kb * 64, lane); continue; }
        r -= I_D;
        if (r < I_IN) { const int kb = r / 224, nb = r % 224, d0 = nb * 32;
            const int sc = d0 < 2048 ? d0 + 1024 : d0 < 3072 ? d0 - 2048 : d0 < 4096 ? 5128 + (d0 - 3072) : d0 < 5120 ? 3080 + (d0 - 4096) : d0 < 6144 ? 4104 + (d0 - 5120) : 6152 + (d0 - 6144);
            tr_item(p->w_in, INW, DM, sc, (bf16u*)(ws + WS_WIN), d0, p->mix_pre_g, scr, kb * 64, lane); continue; }
        r -= I_IN;
        if (r < I_O) { const int kb = r >> 5, nb = r & 31; tr_item(p->w_out, DM, DM, nb * 32, (bf16u*)(ws + WS_WOUT), nb * 32, nullptr, scr, kb * 64, lane); continue; }
        r -= I_O;
        if (r < 2 * I_G) { const bool up = r >= I_G; if (up) r -= I_G; const int kb = r >> 7, nb = r & 127, n0 = nb * 32;
            tr_item(up ? p->f2_wu : p->f2_wg, FF, DM, n0, (bf16u*)(ws + WS_WGU2), (n0 >> 7) * 256 + (n0 & 127) + (up ? 128 : 0), p->f2_pre_g, scr, kb * 64, lane); continue; }
        r -= 2 * I_G;
        { const int kb = r >> 5, nb = r & 31; tr_item(p->f2_wd, DM, FF, nb * 32, (bf16u*)(ws + WS_WD2), nb * 32, nullptr, scr, kb * 64, lane); }
    }
    float* Wf = (float*)(ws + WS_WF);
    for (int i = gtid; i < 8 * DM; i += NGT) { const int h = i >> 10, k = i & 1023; Wf[i] = p->w_in[(size_t)k * INW + 3072 + h] * p->mix_pre_g[k]; }
    bf16u* Wsm = (bf16u*)(ws + WS_WSM);
    for (int i = gtid; i < 8 * 128 * 128; i += NGT) { const int t = (i >> 7) & 127, s = i & 127; Wsm[i] = (bf16u)((s >> 6) <= (t >> 6) ? f2bf(p->w_s[i]) : 0u); }
    bf16u* xb = (bf16u*)(ws + WS_R0); float* rstd0 = (float*)(ws + WS_RSTD0);
    { v4f xv[2][4];
#define P0_LOAD(row0_) do { _Pragma("unroll") for (int n = 0; n < 2; ++n) { const float* xr_ = p->x + (size_t)((row0_) + n * NGW) * DM + 8 * lane; _Pragma("unroll") for (int j = 0; j < 2; ++j) { xv[n][2 * j] = *(const v4f*)(xr_ + 512 * j); xv[n][2 * j + 1] = *(const v4f*)(xr_ + 512 * j + 4); } } } while (0)
      if (gw < T) P0_LOAD(gw);
      for (int row = gw; row < T; row += 2 * NGW) {
        v4f v[2][4]; float ss[2];
#pragma unroll
        for (int n = 0; n < 2; ++n) { float s = 0.f;
#pragma unroll
            for (int j = 0; j < 4; ++j) { v[n][j] = xv[n][j]; s += (v[n][j].x * v[n][j].x + v[n][j].y * v[n][j].y) + (v[n][j].z * v[n][j].z + v[n][j].w * v[n][j].w); }
            ss[n] = s; }
        if (row + 2 * NGW < T) P0_LOAD(row + 2 * NGW);
#pragma unroll
        for (int n = 0; n < 2; ++n) ss[n] = wave_sum(ss[n]);
#pragma unroll
        for (int n = 0; n < 2; ++n) { const int rw = row + n * NGW;
            if (lane == 0) rstd0[rw] = 1.0f / sqrtf(ss[n] * (1.0f / DM) + RMS_EPS);
#pragma unroll
            for (int j = 0; j < 2; ++j) { v4u o; o.x = pk2(v[n][2 * j].x, v[n][2 * j].y); o.y = pk2(v[n][2 * j].z, v[n][2 * j].w); o.z = pk2(v[n][2 * j + 1].x, v[n][2 * j + 1].y); o.w = pk2(v[n][2 * j + 1].z, v[n][2 * j + 1].w);
                *(v4u*)(xb + (size_t)rw * DM + 8 * lane + 512 * j) = o; } }
      }
#undef P0_LOAD
    }
}

template <int NR> __device__ __forceinline__ void row_pass(const float* res, const bf16u* resb, const bf16u* y, const float* __restrict__ gpost, float alpha, float* xout, bf16u* xbo, float* rstd_out,
                                         const LAS float* Wf_l, const float* b_forget, float* logf, int gw, int NGW, int lane) {
    v4f g[4];
#pragma unroll
    for (int j = 0; j < 2; ++j) { g[2 * j] = *(const v4f*)(gpost + 8 * lane + 512 * j); g[2 * j + 1] = *(const v4f*)(gpost + 8 * lane + 512 * j + 4); }
    v4u yw[NR][2], qw[NR][2]; v4f rf[NR][4];
#define RP_LOAD(row0_) do { _Pragma("unroll") for (int n = 0; n < NR; ++n) { const size_t ro_ = (size_t)((row0_) + n * NGW) * DM + 8 * lane; _Pragma("unroll") for (int j = 0; j < 2; ++j) { yw[n][j] = *(const v4u*)(y + ro_ + 512 * j); \
        if (res) { rf[n][2 * j] = *(const v4f*)(res + ro_ + 512 * j); rf[n][2 * j + 1] = *(const v4f*)(res + ro_ + 512 * j + 4); } else qw[n][j] = *(const v4u*)(resb + ro_ + 512 * j); } } } while (0)
    if (gw < T) RP_LOAD(gw);
    for (int row = gw; row < T; row += NR * NGW) {
        v4f r[NR][4], yv[NR][4];
#pragma unroll
        for (int n = 0; n < NR; ++n)
#pragma unroll
            for (int j = 0; j < 2; ++j) { const v4u w = yw[n][j]; yv[n][2 * j] = (v4f){bflo(w.x), bfhi(w.x), bflo(w.y), bfhi(w.y)}; yv[n][2 * j + 1] = (v4f){bflo(w.z), bfhi(w.z), bflo(w.w), bfhi(w.w)};
                if (res) { r[n][2 * j] = rf[n][2 * j]; r[n][2 * j + 1] = rf[n][2 * j + 1]; }
                else { const v4u q = qw[n][j]; r[n][2 * j] = (v4f){bflo(q.x), bfhi(q.x), bflo(q.y), bfhi(q.y)}; r[n][2 * j + 1] = (v4f){bflo(q.z), bfhi(q.z), bflo(q.w), bfhi(q.w)}; } }
        if (row + NR * NGW < T) RP_LOAD(row + NR * NGW);
        float ss[NR];
#pragma unroll
        for (int n = 0; n < NR; ++n) { float s = 0.f;
#pragma unroll
            for (int j = 0; j < 4; ++j) s += (yv[n][j].x * yv[n][j].x + yv[n][j].y * yv[n][j].y) + (yv[n][j].z * yv[n][j].z + yv[n][j].w * yv[n][j].w);
            ss[n] = s; }
#pragma unroll
        for (int n = 0; n < NR; ++n) ss[n] = wave_sum(ss[n]);
#pragma unroll
        for (int n = 0; n < NR; ++n) { const float sc = alpha / sqrtf(ss[n] * (1.0f / DM) + RMS_EPS);
#pragma unroll
            for (int j = 0; j < 4; ++j) r[n][j] = r[n][j] + (yv[n][j] * sc) * g[j]; }
        if (xout) {
#pragma unroll
            for (int n = 0; n < NR; ++n) { const size_t ro = (size_t)(row + n * NGW) * DM + 8 * lane;
#pragma unroll
                for (int j = 0; j < 2; ++j) { *(v4f*)(xout + ro + 512 * j) = r[n][2 * j]; *(v4f*)(xout + ro + 512 * j + 4) = r[n][2 * j + 1]; } } }
        if (xbo) {
            float s2[NR], rs[NR];
#pragma unroll
            for (int n = 0; n < NR; ++n) { float s = 0.f;
#pragma unroll
                for (int j = 0; j < 4; ++j) s += (r[n][j].x * r[n][j].x + r[n][j].y * r[n][j].y) + (r[n][j].z * r[n][j].z + r[n][j].w * r[n][j].w);
                s2[n] = s; }
#pragma unroll
            for (int n = 0; n < NR; ++n) s2[n] = wave_sum(s2[n]);
#pragma unroll
            for (int n = 0; n < NR; ++n) { rs[n] = 1.0f / sqrtf(s2[n] * (1.0f / DM) + RMS_EPS); const size_t ro = (size_t)(row + n * NGW) * DM + 8 * lane;
                if (lane == 0) rstd_out[row + n * NGW] = rs[n];
#pragma unroll
                for (int j = 0; j < 2; ++j) { v4u o; o.x = pk2(r[n][2 * j].x, r[n][2 * j].y); o.y = pk2(r[n][2 * j].z, r[n][2 * j].w); o.z = pk2(r[n][2 * j + 1].x, r[n][2 * j + 1].y); o.w = pk2(r[n][2 * j + 1].z, r[n][2 * j + 1].w);
                    *(v4u*)(xbo + ro + 512 * j) = o; } }
            if (logf) {
#pragma unroll
                for (int n = 0; n < NR; ++n) {
                    float d8[8];
#pragma unroll
                    for (int h = 0; h < 8; ++h) { const LAS float* wf = Wf_l + h * DM + 8 * lane; float d = 0.f;
#pragma unroll
                        for (int j = 0; j < 2; ++j) { const v4f a = *(const LAS v4f*)(wf + 512 * j), b = *(const LAS v4f*)(wf + 512 * j + 4);
                            d += (r[n][2 * j].x * a.x + r[n][2 * j].y * a.y) + (r[n][2 * j].z * a.z + r[n][2 * j].w * a.w) + (r[n][2 * j + 1].x * b.x + r[n][2 * j + 1].y * b.y) + (r[n][2 * j + 1].z * b.z + r[n][2 * j + 1].w * b.w); }
                        d8[h] = d; }
#pragma unroll
                    for (int h = 0; h < 8; ++h) d8[h] += dpp_f<0xB1>(d8[h]);
#pragma unroll
                    for (int h = 0; h < 8; ++h) d8[h] += dpp_f<0x4E>(d8[h]);
#pragma unroll
                    for (int h = 0; h < 8; ++h) d8[h] += dpp_f<0x141>(d8[h]);
#pragma unroll
                    for (int h = 0; h < 8; ++h) d8[h] += dpp_f<0x140>(d8[h]);
#pragma unroll
                    for (int h = 0; h < 8; ++h) d8[h] += swz_xor<16>(d8[h]);
#pragma unroll
                    for (int h = 0; h < 8; ++h) { auto rr = __builtin_amdgcn_permlane32_swap(__float_as_uint(d8[h]), __float_as_uint(d8[h]), false, false); d8[h] = __uint_as_float(rr[0]) + __uint_as_float(rr[1]); }
                    float dsel = d8[0];
#pragma unroll
                    for (int h = 1; h < 8; ++h) dsel = lane == h ? d8[h] : dsel;
                    if (lane < 8) { const float z = dsel * rs[n] + b_forget[lane]; const float ls = fminf(z, 0.f) - log1pf(expf(-fabsf(z))); logf[(size_t)lane * T + row + n * NGW] = ls; }
                }
            }
        }
    }
}

#undef RP_LOAD
__device__ __forceinline__ void cumsum_phase(const float* logf, float* kbias, LAS unsigned char* lds, int bx, int tid, int lane, int wave) {
    if (bx < 32) {
        const int b = bx >> 3, h = bx & 7; LAS float* wt = (LAS float*)lds;
        float v[16]; float run = 0.f;
#pragma unroll
        for (int i = 0; i < 16; ++i) { run += logf[(size_t)h * T + (size_t)b * SEQ + tid * 16 + i]; v[i] = run; }
        float incl = run;
#pragma unroll
        for (int o = 1; o < 64; o <<= 1) { const float t = __int_as_float(__builtin_amdgcn_ds_bpermute(((lane - o) & 63) << 2, __float_as_int(incl))); if (lane >= o) incl += t; }
        if (lane == 63) wt[wave] = incl;
        __syncthreads();
        float base = incl - run;
        for (int w = 0; w < wave; ++w) base += wt[w];
#pragma unroll
        for (int i = 0; i < 16; ++i) kbias[(size_t)bx * SEQ + tid * 16 + i] = -(base + v[i]) * 11.313708498984761f;
    }
    __syncthreads();
}

__device__ __forceinline__ void sgu_phase(PP p, LAS unsigned char* lds, bf16u* U, const bf16u* SV, const bf16u* GB, const bf16u* Wsm, int G, int bx, int tid, int lane, int wave) {
    LAS bf16u* vnT = (LAS bf16u*)lds;
    const int r32 = lane & 31, hi = lane >> 5;
    for (int unit = bx; unit < 2048; unit += G) {
        const int g = unit & 7, win = unit >> 3; const size_t row0 = (size_t)win * 128; const int col0 = g * 128;
        const int tb = (wave & 3) * 32, cbw = (wave >> 2) * 64;
        unsigned short uu[16][2], gg[16][2]; float bsv[16];
            bf16u* ub = U + (row0 + tb) * DM + col0 + cbw; const bf16u* gbp = GB + (row0 + tb) * DM + col0 + cbw; const float* bsp = p->b_s + g * 128 + tb;
            const unsigned eo = (unsigned)(hi * 4 * DM + r32);
#pragma unroll
            for (int r = 0; r < 16; ++r) { const int tc = (r & 3) + 8 * (r >> 2), co = tc * DM; bsv[r] = bsp[tc + 4 * hi];
                uu[r][0] = (ub + co)[eo]; uu[r][1] = (ub + co + 32)[eo]; gg[r][0] = (gbp + co)[eo]; gg[r][1] = (gbp + co + 32)[eo]; }
        { const int r = tid >> 2, q = tid & 3; const bf16u* src = (SV + row0 * DM + col0) + (unsigned)(r * DM + q * 32);
            float v[32];
#pragma unroll
            for (int i = 0; i < 4; ++i) { const v4u w = *(const v4u*)(src + 8 * i);
                v[8 * i] = bflo(w.x); v[8 * i + 1] = bfhi(w.x); v[8 * i + 2] = bflo(w.y); v[8 * i + 3] = bfhi(w.y); v[8 * i + 4] = bflo(w.z); v[8 * i + 5] = bfhi(w.z); v[8 * i + 6] = bflo(w.w); v[8 * i + 7] = bfhi(w.w); }
            float s = 0.f;
#pragma unroll
            for (int i = 0; i < 32; ++i) s += v[i];
            s += swz_xor<1>(s); s += swz_xor<2>(s);
            const float mu = s * (1.0f / 128.0f); float q2 = 0.f;
#pragma unroll
            for (int i = 0; i < 32; ++i) { v[i] -= mu; q2 += v[i] * v[i]; }
            q2 += swz_xor<1>(q2); q2 += swz_xor<2>(q2);
            const float rs = 1.0f / sqrtf(q2 * (1.0f / 128.0f) + LN_EPS);
            const float* lg = p->ln_g + col0 + q * 32; const float* lb = p->ln_b + col0 + q * 32;
#pragma unroll
            for (int i = 0; i < 32; ++i) vnT[(q * 32 + i) * 136 + r] = (bf16u)f2bf(v[i] * rs * lg[i] + lb[i]);
        }
        v8s afr[8];
        { const bf16u* wa = Wsm + ((size_t)(g * 128 + tb + r32)) * 128 + 8 * hi;
#pragma unroll
          for (int kk = 0; kk < 8; ++kk) afr[kk] = *(const v8s*)(wa + 16 * kk); }
        __syncthreads();
        v16f acc0 = {}, acc1 = {};
        const LAS bf16u* vb0 = vnT + (cbw + r32) * 136 + 8 * hi; const LAS bf16u* vb1 = vb0 + 32 * 136;
#pragma unroll
        for (int kk = 0; kk < 8; ++kk) { const v8s a = afr[kk]; const v8s b0 = *(const LAS v8s*)(vb0 + 16 * kk), b1 = *(const LAS v8s*)(vb1 + 16 * kk);
            acc0 = __builtin_amdgcn_mfma_f32_32x32x16_bf16(a, b0, acc0, 0, 0, 0); acc1 = __builtin_amdgcn_mfma_f32_32x32x16_bf16(a, b1, acc1, 0, 0, 0); }
        {
            __builtin_amdgcn_sched_barrier(0);
#pragma unroll
            for (int r = 0; r < 16; ++r) { const int co = ((r & 3) + 8 * (r >> 2)) * DM;
                const float u0 = __uint_as_float((unsigned)uu[r][0] << 16), u1 = __uint_as_float((unsigned)uu[r][1] << 16), g0 = __uint_as_float((unsigned)gg[r][0] << 16), g1 = __uint_as_float((unsigned)gg[r][1] << 16);
                (ub + co)[eo] = (bf16u)f2bf(g0 * u0 * (acc0[r] + bsv[r])); (ub + co + 32)[eo] = (bf16u)f2bf(g1 * u1 * (acc1[r] + bsv[r])); } }
        __syncthreads();
    }
}

__device__ __forceinline__ void attn_phase(unsigned char* lds_g, LAS unsigned char* lds, bf16u* Qb, const bf16u* Kb, const bf16u* Vb, const bf16u* GAb, const bf16u* OBb, const float* kbias, unsigned* ctl, int wave_s) {
    const LAS float* kbl = (const LAS float*)(lds + att::KB_OFF);
    att::FoxCtx cx; cx.Qb = Qb; cx.Kb = Kb; cx.Vb = Vb; cx.GAb = GAb; cx.OBb = OBb; cx.kbias = kbias; cx.ctl = ctl; cx.slot = (volatile LAS unsigned*)(lds + LDS_MISC + 16);
    int tid = fresh_tid(wave_s);
    if (tid == 0) cx.slot[0] = att::fox_fetch(ctl);
    __syncthreads();
    const int n_cur = __builtin_amdgcn_readfirstlane((int)cx.slot[0]);
    __syncthreads();
    if (n_cur >= 1024) return;
    att::BlockRef cur = att::fox_mkref(n_cur, cx, tid & 63);
    att::Seam S;
    bool first = true;
    for (;;) {
        tid = fresh_tid(wave_s);
        { const float* kbg = kbias + (size_t)cur.bh * SEQ; LAS float* kw = (LAS float*)(lds + att::KB_OFF); const int n = cur.P0 + 256;
            for (int i = cur.jlo * 64 + tid * 4; i < n; i += 2048) *(LAS v4f*)(kw + i) = *(const v4f*)(kbg + i);
            __syncthreads(); }
        if (first) { att::fox_prime(cur, (char*)lds_g, S, wave_s); first = false; }
        att::BlockRef nxt; bool last;
        att::fox_block(cur, nxt, last, cx, (char*)lds_g, kbl, S, wave_s);
        if (last) break;
        cur = nxt;
    }
}

#ifndef DOUBLE_STEP
#define DOUBLE_STEP -1
#endif
__global__ void __launch_bounds__(512, 2) fox_gmlp_fwd(Params p_unused) {
    extern __shared__ __attribute__((aligned(16))) unsigned char lds_raw[];
    cg::grid_group grid = cg::this_grid();
    LAS unsigned char* lds = (LAS unsigned char*)lds_raw;
    const int G = gridDim.x, bx = blockIdx.x, NGW = G * 8, NGT = G * 512;
    const int wave_s = __builtin_amdgcn_readfirstlane((int)threadIdx.x >> 6);
    volatile LAS unsigned* bst = (volatile LAS unsigned*)(lds + LDS_MISC);
    if (threadIdx.x < 2) bst[threadIdx.x] = 0u;
    grid.sync();
    { PP p0 = (PP)__builtin_amdgcn_kernarg_segment_ptr(); if (threadIdx.x == 0) (void)xb_add((unsigned*)(p0->ws + WS_BAR) + XB_XCNT(xb_xcc_id()), 1u); }
#pragma unroll 1
    for (int it = 0; it < 13 + (DOUBLE_STEP >= 0 ? 1 : 0); ++it) {
        const int step = (DOUBLE_STEP >= 0 && it > DOUBLE_STEP) ? it - 1 : it;
        const int tid = fresh_tid(wave_s);
        const int lane = tid & 63, wave = wave_s, gw = bx * 8 + wave, gtid = bx * 512 + tid;
        PP p = (PP)__builtin_amdgcn_kernarg_segment_ptr(); asm volatile("" : "+s"(p));
        unsigned char* ws = p->ws;
        bf16u* R0 = (bf16u*)(ws + WS_R0); bf16u* S0 = (bf16u*)(ws + WS_S0); bf16u* S1 = (bf16u*)(ws + WS_S1); bf16u* S2 = (bf16u*)(ws + WS_S2); bf16u* S3 = (bf16u*)(ws + WS_S3); bf16u* S4 = (bf16u*)(ws + WS_S4);
        float* rstd0 = (float*)(ws + WS_RSTD0); float* rstd1 = (float*)(ws + WS_RSTD1); float* rstd2 = (float*)(ws + WS_RSTD2);
        float* logf = (float*)(ws + WS_LOGF); float* kbias = (float*)(ws + WS_KBIAS);
        if (step == 0) {
            p0_prologue(p, lds, gw, NGW, lane, wave, gtid, NGT);
        } else if (step == 1 || step == 10) {
            const bool second = step == 10;
            pg8::Gemm g{R0, (const bf16u*)(ws + (second ? WS_WGU2 : WS_WGU1)), T, 2 * FF, DM}; pg8::StaticOrder S; S.init(T, 2 * FF, G, bx);
            pg8::EpiSwiGLU E{S0, second ? rstd2 : rstd0};
            pg8::gemm_phase<pg8::EpiSwiGLU, pg8::StaticOrder, true, true>(lds, g, S, E, wave_s);
        } else if (step == 2 || step == 8 || step == 11) {
            const bf16u* A = step == 8 ? S3 : S0; const bf16u* Bt = (const bf16u*)(ws + (step == 2 ? WS_WD1 : step == 8 ? WS_WOUT : WS_WD2));
            bf16u* Y = step == 8 ? S0 : S4; const int K = step == 8 ? DM : FF;
            pg8::Gemm g{A, Bt, T, DM, K}; pg8::StaticOrder S; S.init(T, DM, G, bx);
            pg8::EpiBf16<0> E{Y, DM, nullptr, 0, 0, 1.f};
            pg8::gemm_phase<pg8::EpiBf16<0>, pg8::StaticOrder, true, true>(lds, g, S, E, wave_s);
        } else if (step == 3 || step == 9 || step == 12) {
            if (step == 3) {
                LAS float* wfl = (LAS float*)lds; const float* Wf = (const float*)(ws + WS_WF);
                for (int i = tid * 4; i < 8 * DM; i += 2048) *(LAS v4f*)(wfl + i) = *(const v4f*)(Wf + i);
                __syncthreads();
                row_pass<1>(p->x, nullptr, S4, p->f1_post_g, 0.5f, nullptr, R0, rstd1, wfl, p->b_forget, logf, gw, NGW, lane);
            } else if (step == 9) {
                row_pass<2>(nullptr, R0, S0, p->mix_post_g, 1.0f, nullptr, R0, rstd2, nullptr, nullptr, nullptr, gw, NGW, lane);
            } else {
                row_pass<2>(nullptr, R0, S4, p->f2_post_g, 0.5f, p->out, nullptr, nullptr, nullptr, nullptr, nullptr, gw, NGW, lane);
            }
        } else if (step == 4 || step == 6) {
            if (step == 4) cumsum_phase(logf, kbias, lds, bx, tid, lane, wave);
            const bool a = step == 4;
            pg8::Gemm g{R0, (const bf16u*)(ws + WS_WIN) + (a ? (size_t)4096 * DM : 0), T, a ? 3072 : 4096, DM}; pg8::StaticOrder S; S.init(T, a ? 3072 : 4096, G, bx);
            pg8::EpiMix E{a ? S0 : S1, (size_t)32 * MiB, a ? 0 : 1, rstd1, (unsigned*)(ws + WS_BAR) + att::CW_NRM};
            pg8::gemm_phase<pg8::EpiMix, pg8::StaticOrder, true, true>(lds, g, S, E, wave_s);
        } else if (step == 5) {
            sgu_phase(p, lds, S0, S1, S2, (const bf16u*)(ws + WS_WSM), G, bx, tid, lane, wave);
        } else if (step == 7) {
            attn_phase(lds_raw, lds, S3, S1, S2, S4, S0, kbias, (unsigned*)(ws + WS_BAR), wave_s);
        }
        if (it != 12 + (DOUBLE_STEP >= 0 ? 1 : 0)) xcd_barrier((unsigned*)(ws + WS_BAR), bst, wave_s == 0 && lane == 0);
    }
}

extern "C" void kernel_launch(void* const* d_in, const int* in_sizes, int n_in, void* d_out, int out_size, void* d_ws, size_t ws_size, hipStream_t stream) {
    static int grid = 0;
    if (grid == 0) {
        if (n_in != 20 || in_sizes[0] != T * DM || out_size != T * DM || ws_size < WS_END) {
            fprintf(stderr, "kernel_launch: unexpected shapes (n_in %d, in0 %d, out %d, ws %zu); nothing launched\n", n_in, n_in > 0 ? in_sizes[0] : -1, out_size, ws_size); grid = -1; return; }
        int dev = 0, cus = 0, per_cu = 0;
        (void)hipGetDevice(&dev); (void)hipDeviceGetAttribute(&cus, hipDeviceAttributeMultiprocessorCount, dev);
        if (hipFuncSetAttribute((const void*)fox_gmlp_fwd, hipFuncAttributeMaxDynamicSharedMemorySize, LDS_TOTAL) != hipSuccess) { fprintf(stderr, "kernel_launch: hipFuncSetAttribute failed\n"); grid = -1; return; }
        if (hipOccupancyMaxActiveBlocksPerMultiprocessor(&per_cu, (const void*)fox_gmlp_fwd, 512, LDS_TOTAL) != hipSuccess || per_cu < 1) { fprintf(stderr, "kernel_launch: occupancy query says %d\n", per_cu); per_cu = 1; }
        (void)hipGetLastError();
        if (per_cu > 1) per_cu = 1;
        grid = cus * per_cu;
    }
    if (grid < 0) return;
    Params p{};
    p.x = (const float*)d_in[0]; p.f1_pre_g = (const float*)d_in[1]; p.f1_wg = (const float*)d_in[2]; p.f1_wu = (const float*)d_in[3]; p.f1_wd = (const float*)d_in[4]; p.f1_post_g = (const float*)d_in[5];
    p.mix_pre_g = (const float*)d_in[6]; p.w_in = (const float*)d_in[7]; p.b_forget = (const float*)d_in[8]; p.ln_g = (const float*)d_in[9]; p.ln_b = (const float*)d_in[10]; p.w_s = (const float*)d_in[11]; p.b_s = (const float*)d_in[12];
    p.w_out = (const float*)d_in[13]; p.mix_post_g = (const float*)d_in[14]; p.f2_pre_g = (const float*)d_in[15]; p.f2_wg = (const float*)d_in[16]; p.f2_wu = (const float*)d_in[17]; p.f2_wd = (const float*)d_in[18]; p.f2_post_g = (const float*)d_in[19];
    p.out = (float*)d_out; p.ws = (unsigned char*)d_ws;
    if (hipMemsetAsync((char*)d_ws + WS_BAR, 0, BAR_BYTES, stream) != hipSuccess) { fprintf(stderr, "kernel_launch: hipMemsetAsync failed\n"); return; }
    void* args[] = {&p};
    hipError_t e = hipLaunchCooperativeKernel((const void*)fox_gmlp_fwd, dim3(grid), dim3(512), args, LDS_TOTAL, stream);
    if (e != hipSuccess) fprintf(stderr, "kernel_launch: cooperative launch failed: %s (grid %d)\n", hipGetErrorString(e), grid);
}
```

```cpp
#include <hip/hip_runtime.h>
#include <hip/hip_cooperative_groups.h>
#include <hip/hip_bf16.h>
#include <cstdio>
#include <cstdint>
namespace cg = cooperative_groups;
namespace pg8 {
#define PG8_LAS __attribute__((address_space(3)))
typedef unsigned short bf16_t;
typedef short bf16x8 __attribute__((ext_vector_type(8)));
typedef float f32x4 __attribute__((ext_vector_type(4)));
typedef unsigned u32x4 __attribute__((ext_vector_type(4)));
constexpr int BM = 256, BK = 64, HALF = 128, HTB = HALF * BK * 2  , STAGE_BYTES = 8 * HTB, NXCD = 8, WGM = 8;

__host__ __device__ __forceinline__ int lds_byte(int r, int c) { const int st = (r >> 4) * 2 + (c >> 5), rr = r & 15, cc = c & 31, ob = rr * 64 + cc * 2; return st * 1024 + (ob ^ (((ob >> 9) & 1) << 5)); }
__host__ __device__ __forceinline__ void stage_rc(int b, int& R, int& C) { const int st = b / 1024, sb = b % 1024, swz = sb ^ (((sb >> 9) & 1) << 5); R = (st >> 1) * 16 + swz / 64; C = (st & 1) * 32 + (swz % 64) / 2; }
__host__ __device__ __forceinline__ int perm32(int rho) { const int n = rho >> 4, i = rho & 15; return 8 * (i >> 2) + 4 * n + (i & 3); }

struct Unit { int pm, pn; };
struct Gemm { const bf16_t* A; const bf16_t* Bt; int M, N, K; };

struct StaticOrder {
    int nM, nN, nwg, G, c;
    __host__ __device__ void init(int M, int N, int G_, int c_) { nM = M / BM; nN = N / BM; nwg = nM * nN; G = G_; c = c_; }
    __host__ __device__ bool next(int i, Unit& u) const {
        const long L = (long)i * G + c; if (L >= nwg) return false;
        int wgid = (int)L; { const int q = nwg / NXCD, r = nwg % NXCD, xcd = wgid % NXCD, off = wgid / NXCD; wgid = (xcd < r ? xcd * (q + 1) : r * (q + 1) + (xcd - r) * q) + off; }
        const int nig = WGM * nN, gid = wgid / nig, fm = gid * WGM, gsz = (nM - fm) < WGM ? (nM - fm) : WGM;
        u.pm = fm + ((wgid % nig) % gsz); u.pn = (wgid % nig) / gsz; return true;
    }
    __device__ __forceinline__ void a_ready(const Unit&) const {}
    __device__ __forceinline__ void done(const Unit&) const {}
};

typedef float cvt_f32x2 __attribute__((ext_vector_type(2))); typedef __bf16 cvt_bf16x2 __attribute__((ext_vector_type(2)));
__device__ __forceinline__ unsigned cvt_pk_bf16(float lo, float hi) { cvt_f32x2 v = {lo, hi}; cvt_bf16x2 b = __builtin_convertvector(v, cvt_bf16x2); return __builtin_bit_cast(unsigned, b); }
typedef float f32x2 __attribute__((ext_vector_type(2)));
__device__ __forceinline__ f32x2 gelu_pk(f32x2 v) {
    const f32x2 av = __builtin_elementwise_abs(v), d = av * 0.2316418882f + 1.0f;
    f32x2 t; t.x = __builtin_amdgcn_rcpf(d.x); t.y = __builtin_amdgcn_rcpf(d.y);
    f32x2 q = t * 0.5307027145f + (-0.7265760135f); q = q * t + 0.7107068705f; q = q * t + (-0.142248368f); q = q * t + 0.127414796f; q = q * t;
    const f32x2 s = (v * v) * (-0.72134752044f);
    f32x2 e; e.x = __builtin_amdgcn_exp2f(s.x); e.y = __builtin_amdgcn_exp2f(s.y);
    const f32x2 m = v * (q * e), r = v - m;
    f32x2 o; o.x = v.x < 0.f ? m.x : r.x; o.y = v.y < 0.f ? m.y : r.y; return o;
}

template <int ACT  > struct EpiBf16 {
    static constexpr bool PERM = true, AFTER_DRAIN = false, RSTD_LDS = false; static_assert(ACT == 0 || ACT == 1, "EpiBf16: ACT is 0 (none) or 1 (gelu_pk)");
    bf16_t* O; int ldc; const float* bias; int split_cols; size_t split_stride; float scale0;
    __device__ __forceinline__ void operator()(const f32x4 (&acc)[2][2][4][2], const Unit& u, int wr, int wc, int fr, int fq) const {
        const int row0 = u.pm * BM + wr * 64 + fr; int colt = u.pn * BM; bf16_t* base = O;
        float sc = 1.f; if (split_cols) { const int t = colt / split_cols; base += (size_t)t * split_stride; colt -= t * split_cols; if (t == 0) sc = scale0; }
        const int col0 = colt + wc * 32 + 8 * fq, bcol0 = u.pn * BM + wc * 32 + 8 * fq;
        f32x4 bv[2][2];
#pragma unroll
        for (int bj = 0; bj < 2; ++bj)
#pragma unroll
            for (int n = 0; n < 2; ++n) bv[bj][n] = bias ? *(const f32x4*)(bias + bcol0 + bj * HALF + 4 * n) : (f32x4){0.f, 0.f, 0.f, 0.f};
#pragma unroll
        for (int ai = 0; ai < 2; ++ai)
#pragma unroll
            for (int m = 0; m < 4; ++m) { bf16_t* rowp = base + (size_t)(row0 + ai * HALF + m * 16) * ldc + col0;
#pragma unroll
                for (int bj = 0; bj < 2; ++bj) { f32x4 v0 = acc[ai][bj][m][0] + bv[bj][0], v1 = acc[ai][bj][m][1] + bv[bj][1];
                    if (ACT == 1) { f32x2 a = gelu_pk((f32x2){v0[0], v0[1]}), b = gelu_pk((f32x2){v0[2], v0[3]}), c = gelu_pk((f32x2){v1[0], v1[1]}), d = gelu_pk((f32x2){v1[2], v1[3]});
                        v0 = (f32x4){a.x, a.y, b.x, b.y}; v1 = (f32x4){c.x, c.y, d.x, d.y}; }
                    v0 = v0 * sc; v1 = v1 * sc; u32x4 w; w.x = cvt_pk_bf16(v0[0], v0[1]); w.y = cvt_pk_bf16(v0[2], v0[3]); w.z = cvt_pk_bf16(v1[0], v1[1]); w.w = cvt_pk_bf16(v1[2], v1[3]);
                    *(u32x4*)(rowp + bj * HALF) = w; } }
    }
};

__device__ __forceinline__ float sigmoid_f(float x) { return __builtin_amdgcn_rcpf(1.0f + __builtin_amdgcn_exp2f(-1.4426950408889634f * x)); }
struct EpiSwiGLU {
    static constexpr bool PERM = true, AFTER_DRAIN = false, RSTD_LDS = true;
    bf16_t* O; const float* rstd;
    __device__ __forceinline__ void operator()(const f32x4 (&acc)[2][2][4][2], const Unit& u, int wr, int wc, int fr, int fq, const PG8_LAS float* rl) const {
        const int row0 = u.pm * BM + wr * 64 + fr, col0 = u.pn * HALF + wc * 32 + 8 * fq; rl += wr * 64 + fr;
#pragma unroll
        for (int ai = 0; ai < 2; ++ai)
#pragma unroll
            for (int m = 0; m < 4; ++m) { const int row = row0 + ai * HALF + m * 16; const float rs = rl[ai * HALF + m * 16];
                u32x4 w; unsigned wv[4];
#pragma unroll
                for (int n = 0; n < 2; ++n) { const f32x4 g = acc[ai][0][m][n] * rs, up = acc[ai][1][m][n] * rs; float o[4];
#pragma unroll
                    for (int j = 0; j < 4; ++j) o[j] = g[j] * sigmoid_f(g[j]) * up[j];
                    wv[2 * n] = cvt_pk_bf16(o[0], o[1]); wv[2 * n + 1] = cvt_pk_bf16(o[2], o[3]); }
                w.x = wv[0]; w.y = wv[1]; w.z = wv[2]; w.w = wv[3];
                *(u32x4*)(O + (size_t)row * 4096 + col0) = w; }
    }
};
struct EpiMix {
    static constexpr bool PERM = true, AFTER_DRAIN = false, RSTD_LDS = true;
    bf16_t* O; size_t stride; int mode; const float* rstd;
    unsigned* nrm;
    template <int ACT> __device__ __forceinline__ void body(const f32x4 (&acc)[2][2][4][2], bf16_t* base, int row0, int col0, const PG8_LAS float* rl) const {
#pragma unroll
        for (int ai = 0; ai < 2; ++ai)
#pragma unroll
            for (int m = 0; m < 4; ++m) { const int row = row0 + ai * HALF + m * 16; const float rs = rl[ai * HALF + m * 16]; bf16_t* rowp = base + (size_t)row * 1024 + col0;
#pragma unroll
                for (int bj = 0; bj < 2; ++bj) { f32x4 v0 = acc[ai][bj][m][0] * rs, v1 = acc[ai][bj][m][1] * rs;
                    if (ACT == 1) { f32x2 a = gelu_pk((f32x2){v0[0], v0[1]}), b = gelu_pk((f32x2){v0[2], v0[3]}), c = gelu_pk((f32x2){v1[0], v1[1]}), d = gelu_pk((f32x2){v1[2], v1[3]});
                        v0 = (f32x4){a.x, a.y, b.x, b.y}; v1 = (f32x4){c.x, c.y, d.x, d.y}; }
                    if (ACT == 2) {
#pragma unroll
                        for (int j = 0; j < 4; ++j) { v0[j] = sigmoid_f(v0[j]); v1[j] = sigmoid_f(v1[j]); } }
                    u32x4 w; w.x = cvt_pk_bf16(v0[0], v0[1]); w.y = cvt_pk_bf16(v0[2], v0[3]); w.z = cvt_pk_bf16(v1[0], v1[1]); w.w = cvt_pk_bf16(v1[2], v1[3]);
                    *(u32x4*)(rowp + bj * HALF) = w; } }
    }
    __device__ __forceinline__ void operator()(const f32x4 (&acc)[2][2][4][2], const Unit& u, int wr, int wc, int fr, int fq, const PG8_LAS float* rl) const {
        rl += wr * 64 + fr;
        const int t = (u.pn * BM) >> 10, colt = u.pn * BM - (t << 10);
        bf16_t* base = O + (size_t)t * stride; const int a = mode == 0 ? (t < 2 ? 1 : 2) : (t == 3 ? 2 : 0);
        const int row0 = u.pm * BM + wr * 64 + fr, col0 = colt + wc * 32 + 8 * fq;
        if (a == 0) body<0>(acc, base, row0, col0, rl); else if (a == 1) body<1>(acc, base, row0, col0, rl); else body<2>(acc, base, row0, col0, rl);
        if (mode == 1 && (t == 0 || t == 2)) {
            float mx[2] = {0.f, 0.f};
#pragma unroll
            for (int ai = 0; ai < 2; ++ai)
#pragma unroll
                for (int m = 0; m < 4; ++m) { const float rs = rl[ai * HALF + m * 16];
#pragma unroll
                    for (int bj = 0; bj < 2; ++bj) { const f32x4 v0 = acc[ai][bj][m][0] * rs, v1 = acc[ai][bj][m][1] * rs;
                        float s = (v0[0] * v0[0] + v0[1] * v0[1]) + (v0[2] * v0[2] + v0[3] * v0[3]) + (v1[0] * v1[0] + v1[1] * v1[1]) + (v1[2] * v1[2] + v1[3] * v1[3]);
                        s += __int_as_float(__builtin_amdgcn_ds_swizzle(__float_as_int(s), (16 << 10) | 0x1f));
                        { auto rr = __builtin_amdgcn_permlane32_swap(__float_as_uint(s), __float_as_uint(s), false, false); s = __uint_as_float(rr[0]) + __uint_as_float(rr[1]); }
                        mx[bj] = fmaxf(mx[bj], s); } }
#pragma unroll
            for (int bj = 0; bj < 2; ++bj) { float v = mx[bj];
                v = fmaxf(v, __int_as_float(__builtin_amdgcn_ds_swizzle(__float_as_int(v), (1 << 10) | 0x1f))); v = fmaxf(v, __int_as_float(__builtin_amdgcn_ds_swizzle(__float_as_int(v), (2 << 10) | 0x1f)));
                v = fmaxf(v, __int_as_float(__builtin_amdgcn_ds_swizzle(__float_as_int(v), (4 << 10) | 0x1f))); v = fmaxf(v, __int_as_float(__builtin_amdgcn_ds_swizzle(__float_as_int(v), (8 << 10) | 0x1f)));
                mx[bj] = v; }
            if (fr == 0 && fq == 0) { const int b = u.pm >> 5;
#pragma unroll
                for (int bj = 0; bj < 2; ++bj) { const int bh = b * 8 + (u.pn & 3) * 2 + bj; atomicMax(nrm + ((bh * 2 + (t == 0 ? 1 : 0)) * 4 + wc), __float_as_uint(mx[bj])); } }
        }
    }
};
template <class Epi, class Sched, bool ALIGN_EPI = false, bool SP2 = false>
__device__ __forceinline__ void gemm_phase(PG8_LAS unsigned char* lds, const Gemm g, const Sched& S, const Epi& E, int wave_s) {
    int tid = 0; asm volatile("" : "+v"(tid)); tid = wave_s * 64 + (int)__builtin_amdgcn_mbcnt_hi(~0u, __builtin_amdgcn_mbcnt_lo(~0u, (unsigned)tid)); asm volatile("" : "+v"(tid));
    const int wid = __builtin_amdgcn_readfirstlane(tid >> 6), lane = tid & 63, wr = wid >> 2, wc = wid & 3, fr = lane & 15, fq = lane >> 4;
    const int K = g.K, nt = K / BK;
    unsigned voffA[2], voffB[2];
#pragma unroll
    for (int i = 0; i < 2; ++i) { int R, C; stage_rc(tid * 16 + i * 8192, R, C); const int Rb = Epi::PERM ? ((R & ~31) + perm32(R & 31)) : R;
        voffA[i] = (unsigned)(R * K + C) * 2u; voffB[i] = (unsigned)(Rb * K + C) * 2u; }
    const size_t kstep = (size_t)(BK * 2);
    const size_t hstep = (size_t)HALF * K * 2;
    const size_t tstep = 2 * hstep;
    const unsigned ldsw = (unsigned)wid * 1024u;
    const int aoff = lds_byte(wr * 64 + fr, fq * 8), boff = lds_byte(wc * 32 + fr, fq * 8);
#define PG8_SA(b, h) (((b) * 2 + (h)) * HTB)
#define PG8_SB(b, h) ((4 + (b) * 2 + (h)) * HTB)
#define PG8_STAGE(bufoff, gbase, voff) do { _Pragma("unroll") for (int _i = 0; _i < 2; ++_i) \
        __builtin_amdgcn_global_load_lds((const unsigned*)((const char*)(gbase) + (voff)[_i]), (PG8_LAS unsigned*)(lds + (bufoff) + ldsw + _i * 8192), 16, 0, 0); } while (0)
#define PG8_LDA(dst, b, h) do { _Pragma("unroll") for (int m = 0; m < 4; ++m) _Pragma("unroll") for (int k = 0; k < 2; ++k) dst[m][k] = *(const PG8_LAS bf16x8*)(lds + PG8_SA(b, h) + aoff + m * 2048 + k * 1024); } while (0)
#define PG8_LDB(dst, b, h) do { _Pragma("unroll") for (int n = 0; n < 2; ++n) _Pragma("unroll") for (int k = 0; k < 2; ++k) dst[n][k] = *(const PG8_LAS bf16x8*)(lds + PG8_SB(b, h) + boff + n * 2048 + k * 1024); } while (0)
#define PG8_MMA(ai, bj, At, Bt) do { __builtin_amdgcn_s_setprio(1); _Pragma("unroll") for (int m = 0; m < 4; ++m) _Pragma("unroll") for (int n = 0; n < 2; ++n) _Pragma("unroll") for (int k = 0; k < 2; ++k) \
        acc[ai][bj][m][n] = __builtin_amdgcn_mfma_f32_16x16x32_bf16(Bt[n][k], At[m][k], acc[ai][bj][m][n], 0, 0, 0); __builtin_amdgcn_s_setprio(0); } while (0)
#define PG8_WAIT_V(n) asm volatile("s_waitcnt vmcnt(" #n ")" ::: "memory")
#define PG8_WAIT_L(n) asm volatile("s_waitcnt lgkmcnt(" #n ")" ::: "memory")
#define PG8_BAR __builtin_amdgcn_s_barrier()
#define PG8_SCHED __builtin_amdgcn_sched_barrier(0)
    Unit cur, nxt; int ui = 0;
    if (!S.next(0, cur)) return;
    f32x4 acc[2][2][4][2];
#pragma unroll
    for (int a = 0; a < 2; ++a)
#pragma unroll
        for (int b = 0; b < 2; ++b)
#pragma unroll
            for (int m = 0; m < 4; ++m)
#pragma unroll
                for (int n = 0; n < 2; ++n) acc[a][b][m][n] = (f32x4){0.f, 0.f, 0.f, 0.f};
    bf16x8 At[4][2], B0[2][2], B1[2][2];
    const char* cA = (const char*)g.A + (size_t)cur.pm * tstep; const char* cB = (const char*)g.Bt + (size_t)cur.pn * tstep;
    S.a_ready(cur);
    if constexpr (Epi::RSTD_LDS) { if (wid < 4) __builtin_amdgcn_global_load_lds((const unsigned*)(E.rstd + cur.pm * BM + wid * 64 + lane), (PG8_LAS unsigned*)(lds + STAGE_BYTES + wid * 256), 4, 0, 0); }
    if constexpr (SP2) {
        PG8_STAGE(PG8_SB(0, 0), cB, voffB); PG8_STAGE(PG8_SB(0, 1), cB + hstep, voffB); PG8_STAGE(PG8_SA(0, 0), cA, voffA); PG8_STAGE(PG8_SA(0, 1), cA + hstep, voffA);
        if (wr == 1) PG8_BAR;
        PG8_WAIT_V(2); PG8_BAR;
        PG8_STAGE(PG8_SB(1, 0), cB + kstep, voffB); PG8_STAGE(PG8_SA(1, 0), cA + kstep, voffA); PG8_STAGE(PG8_SB(1, 1), cB + hstep + kstep, voffB);
        PG8_WAIT_V(6); PG8_BAR;
    } else {
        PG8_STAGE(PG8_SB(0, 0), cB, voffB); PG8_STAGE(PG8_SA(0, 0), cA, voffA); PG8_STAGE(PG8_SB(0, 1), cB + hstep, voffB); PG8_STAGE(PG8_SA(0, 1), cA + hstep, voffA);
        if (wr == 1) PG8_BAR;
        PG8_WAIT_V(4); PG8_BAR;
        PG8_STAGE(PG8_SB(1, 0), cB + kstep, voffB); PG8_STAGE(PG8_SA(1, 0), cA + kstep, voffA); PG8_STAGE(PG8_SB(1, 1), cB + hstep + kstep, voffB);
        PG8_WAIT_V(6); PG8_BAR;
    }
    for (;;) {
        const bool has_next = S.next(ui + 1, nxt);
        const char* nA = has_next ? (const char*)g.A + (size_t)nxt.pm * tstep : cA; const char* nB = has_next ? (const char*)g.Bt + (size_t)nxt.pn * tstep : cB;
        for (int t = 0; t < nt; t += 2) {
            const bool last = (t == nt - 2);
            const char* a1 = cA + (size_t)(t + 1) * kstep;
            const char* a2 = last ? nA : cA + (size_t)(t + 2) * kstep; const char* b2 = last ? nB : cB + (size_t)(t + 2) * kstep;
            const char* a3 = a2 + kstep; const char* b3 = b2 + kstep;
            if (last && has_next) S.a_ready(nxt);
            if constexpr (Epi::RSTD_LDS) { if (last && has_next && wid < 4) __builtin_amdgcn_global_load_lds((const unsigned*)(E.rstd + nxt.pm * BM + wid * 64 + lane), (PG8_LAS unsigned*)(lds + STAGE_BYTES + ((ui + 1) & 1) * 1024 + wid * 256), 4, 0, 0); }
            if constexpr (SP2) {
            PG8_LDB(B0, 0, 0); PG8_LDB(B1, 0, 1); PG8_SCHED; PG8_LDA(At, 0, 0); PG8_STAGE(PG8_SA(1, 1), a1 + hstep, voffA);
            PG8_WAIT_V(8); PG8_WAIT_L(0); PG8_BAR; PG8_MMA(0, 0, At, B0); PG8_MMA(0, 1, At, B1); PG8_BAR; PG8_SCHED;
            PG8_LDA(At, 0, 1); PG8_STAGE(PG8_SB(0, 0), b2, voffB); PG8_STAGE(PG8_SB(0, 1), b2 + hstep, voffB); PG8_STAGE(PG8_SA(0, 0), a2, voffA);
            PG8_WAIT_V(8); PG8_WAIT_L(0); PG8_BAR; PG8_MMA(1, 0, At, B0); PG8_MMA(1, 1, At, B1); PG8_BAR; PG8_SCHED;
            PG8_LDB(B0, 1, 0); PG8_LDB(B1, 1, 1); PG8_SCHED; PG8_LDA(At, 1, 0); PG8_STAGE(PG8_SA(0, 1), a2 + hstep, voffA);
            PG8_WAIT_V(8); PG8_WAIT_L(0); PG8_BAR; PG8_MMA(0, 0, At, B0); PG8_MMA(0, 1, At, B1); PG8_BAR; PG8_SCHED;
            PG8_LDA(At, 1, 1); PG8_STAGE(PG8_SB(1, 0), b3, voffB); PG8_STAGE(PG8_SB(1, 1), b3 + hstep, voffB); PG8_STAGE(PG8_SA(1, 0), a3, voffA);
            PG8_WAIT_V(8); PG8_WAIT_L(0); PG8_BAR; PG8_MMA(1, 0, At, B0); PG8_MMA(1, 1, At, B1); PG8_BAR; PG8_SCHED;
            } else {
            PG8_LDB(B0, 0, 0); PG8_SCHED; PG8_LDA(At, 0, 0); PG8_STAGE(PG8_SA(1, 1), a1 + hstep, voffA);
            PG8_WAIT_L(8); PG8_BAR; PG8_WAIT_L(0); PG8_MMA(0, 0, At, B0); PG8_BAR; PG8_SCHED;
            PG8_LDB(B1, 0, 1); PG8_STAGE(PG8_SB(0, 0), b2, voffB);
            PG8_BAR; PG8_WAIT_L(0); PG8_MMA(0, 1, At, B1); PG8_BAR;
            PG8_LDA(At, 0, 1); PG8_STAGE(PG8_SA(0, 0), a2, voffA);
            PG8_BAR; PG8_WAIT_L(0); PG8_MMA(1, 0, At, B0); PG8_BAR; PG8_SCHED;
            PG8_STAGE(PG8_SB(0, 1), b2 + hstep, voffB);
            PG8_WAIT_V(6); PG8_BAR; PG8_MMA(1, 1, At, B1); PG8_BAR;
            PG8_LDB(B0, 1, 0); PG8_SCHED; PG8_LDA(At, 1, 0); PG8_STAGE(PG8_SA(0, 1), a2 + hstep, voffA);
            PG8_WAIT_L(8); PG8_BAR; PG8_WAIT_L(0); PG8_MMA(0, 0, At, B0); PG8_BAR; PG8_SCHED;
            PG8_LDB(B1, 1, 1); PG8_STAGE(PG8_SB(1, 0), b3, voffB);
            PG8_BAR; PG8_WAIT_L(0); PG8_MMA(0, 1, At, B1); PG8_BAR;
            PG8_LDA(At, 1, 1); PG8_STAGE(PG8_SA(1, 0), a3, voffA);
            PG8_BAR; PG8_WAIT_L(0); PG8_MMA(1, 0, At, B0); PG8_BAR; PG8_SCHED;
            PG8_STAGE(PG8_SB(1, 1), b3 + hstep, voffB);
            PG8_WAIT_V(6); PG8_BAR; PG8_MMA(1, 1, At, B1); PG8_BAR;
            }
        }
        if constexpr (ALIGN_EPI) { if (wr == 0) PG8_BAR; }
        if constexpr (!Epi::AFTER_DRAIN) { if constexpr (Epi::RSTD_LDS) E(acc, cur, wr, wc, fr, fq, (const PG8_LAS float*)(lds + STAGE_BYTES + (ui & 1) * 1024)); else E(acc, cur, wr, wc, fr, fq); S.done(cur); }
        if (!has_next) break;
#pragma unroll
        for (int a = 0; a < 2; ++a)
#pragma unroll
            for (int b = 0; b < 2; ++b)
#pragma unroll
                for (int m = 0; m < 4; ++m)
#pragma unroll
                    for (int n = 0; n < 2; ++n) acc[a][b][m][n] = (f32x4){0.f, 0.f, 0.f, 0.f};
        cur = nxt; cA = nA; cB = nB; ++ui;
        if constexpr (ALIGN_EPI) { if (wr == 1) PG8_BAR; }
    }
    PG8_WAIT_V(0);
    if constexpr (!ALIGN_EPI) { if (wr == 0) PG8_BAR; }
    PG8_BAR;
    if constexpr (Epi::AFTER_DRAIN) { E.fused(acc, cur, wr, wc, fr, fq, lds, wid, lane); S.done(cur); }
#undef PG8_SA
#undef PG8_SB
#undef PG8_STAGE
#undef PG8_LDA
#undef PG8_LDB
#undef PG8_MMA
#undef PG8_WAIT_V
#undef PG8_WAIT_L
#undef PG8_BAR
#undef PG8_SCHED
}
}

namespace att {
#define ALAS __attribute__((address_space(3)))
constexpr int D = 128, RS = 1024;
constexpr float SCALE = 0.08838834764831845f;
constexpr float THR = 8.f;
constexpr bool WSKIP = false;
constexpr int NW = 8, QBLK = 32, KVBLK = 64, QB = NW * QBLK;
constexpr int SHM_V = KVBLK * D * 2, SHM_K = KVBLK * D * 2;
constexpr int LDS_CORE = 2 * SHM_V + 2 * SHM_K + NW * 64 * 4;
constexpr int KB_OFF = LDS_CORE;
constexpr int LDS_BYTES = KB_OFF + 8192 * 4;
using bf16 = __hip_bfloat16;
typedef short bf16x8 __attribute__((ext_vector_type(8)));
typedef short s16x4 __attribute__((ext_vector_type(4)));
typedef float f32x16 __attribute__((ext_vector_type(16)));
typedef float f32x4 __attribute__((ext_vector_type(4)));
typedef unsigned u32x4 __attribute__((ext_vector_type(4)));
template <class A, class Bt> struct same_t { static constexpr bool v = false; };
template <class A> struct same_t<A, A> { static constexpr bool v = true; };

#define KSWZ(row, colB) ((row) * 256 + ((colB) ^ (((row) & 7) << 4)))
#define SBAR() __builtin_amdgcn_sched_barrier(0)
__device__ __forceinline__ int v_st(int k, int c) { const int kk = (k & ~0xC) | ((k & 4) << 1) | ((k & 8) >> 1); return ((kk >> 3) * 4 + (c >> 5)) * 512 + ((kk & 7) * 32 + (c & 31)) * 2; }
__device__ __forceinline__ int v_rd_base(int lane) { return ((lane & 3) << 3) | (((lane >> 2) & 3) << 6) | (((lane >> 4) & 1) << 5) | (((lane >> 5) & 1) << 8); }
constexpr int v_rd_off(int d0, int ks, int half) { return d0 * 512 + ks * 4096 + half * 2048; }
__device__ __forceinline__ int crow(int r, int hi) { return (r & 3) + 8 * (r >> 2) + 4 * hi; }
__device__ __forceinline__ unsigned cvtpk(float lo, float hi) {
    typedef float f32x2_t __attribute__((ext_vector_type(2))); typedef __bf16 bf16x2_t __attribute__((ext_vector_type(2)));
    f32x2_t v = {lo, hi}; bf16x2_t b = __builtin_convertvector(v, bf16x2_t); return __builtin_bit_cast(unsigned, b);
}
__device__ __forceinline__ bf16x8 pack8(f32x4 a, f32x4 b) {
    u32x4 w = {cvtpk(a[0], a[1]), cvtpk(a[2], a[3]), cvtpk(b[0], b[1]), cvtpk(b[2], b[3])};
    return *reinterpret_cast<bf16x8*>(&w);
}
template <class T> __device__ __forceinline__ bf16x8 load8(const T* p) {
    if constexpr (same_t<T, float>::v) { return pack8(*(const f32x4*)p, *(const f32x4*)(p + 4)); }
    else { return *reinterpret_cast<const bf16x8*>(p); }
}
__device__ __forceinline__ void mask_tile(f32x16& p0, f32x16& p1, int dq, unsigned W) {
    const float NEG = -__builtin_inff();
#pragma unroll
    for (int r = 0; r < 16; ++r) {
        const int c = (r & 3) + 8 * (r >> 2);
        if ((unsigned)(dq - c) >= W) p0[r] = NEG;
        if ((unsigned)(dq - c - 32) >= W) p1[r] = NEG;
    }
}
__device__ __forceinline__ void partialSM(f32x16& p0, f32x16& p1, float& m_reg, float& mn, float& alpha) {
    float pmax = p0[0]; for (int r = 1; r < 16; ++r) pmax = fmaxf(pmax, p0[r]); for (int r = 0; r < 16; ++r) pmax = fmaxf(pmax, p1[r]);
    { auto rr = __builtin_amdgcn_permlane32_swap(__float_as_uint(pmax), __float_as_uint(pmax), false, false);
      pmax = fmaxf(__uint_as_float(rr[0]), __uint_as_float(rr[1])); }
    constexpr float C2 = 1.4426950408889634f * SCALE;
    if (__builtin_expect(__all((pmax - m_reg) * SCALE <= THR), 1)) { mn = m_reg; alpha = 1.f; }
    else { mn = fmaxf(m_reg, pmax); alpha = __builtin_amdgcn_exp2f((m_reg - mn) * C2); m_reg = mn; }
    const float mnL = -mn * C2;
    for (int r = 0; r < 16; ++r) p0[r] = fmaf(p0[r], C2, mnL); for (int r = 0; r < 16; ++r) p1[r] = fmaf(p1[r], C2, mnL);
    for (int r = 0; r < 16; ++r) p0[r] = __builtin_amdgcn_exp2f(p0[r]);
}
__device__ __forceinline__ void finishSM(f32x16& p0, f32x16& p1, float alpha, float& l_reg, bf16x8& pa0, bf16x8& pa1, bf16x8& pa2, bf16x8& pa3) {
    for (int r = 0; r < 16; ++r) p1[r] = __builtin_amdgcn_exp2f(p1[r]);
    float ps = 0; for (int r = 0; r < 16; ++r) ps += p0[r]; for (int r = 0; r < 16; ++r) ps += p1[r];
    { auto rr = __builtin_amdgcn_permlane32_swap(__float_as_uint(ps), __float_as_uint(ps), false, false);
      ps = __uint_as_float(rr[0]) + __uint_as_float(rr[1]); }
    l_reg = l_reg * alpha + ps;
#define PK4(P, B_, OUT) do { unsigned a0 = cvtpk(P[B_+0], P[B_+1]), a1 = cvtpk(P[B_+2], P[B_+3]);                          \
        unsigned b0 = cvtpk(P[B_+4], P[B_+5]), b1 = cvtpk(P[B_+6], P[B_+7]);                                             \
        auto r0 = __builtin_amdgcn_permlane32_swap(a0, b0, false, false); auto r1 = __builtin_amdgcn_permlane32_swap(a1, b1, false, false); \
        u32x4 w = {r0[0], r1[0], r0[1], r1[1]}; OUT = *reinterpret_cast<bf16x8*>(&w); } while (0)
    PK4(p0, 0, pa0); PK4(p0, 8, pa1); PK4(p1, 0, pa2); PK4(p1, 8, pa3);
#undef PK4
}
template <int KB>
__device__ __forceinline__ void qkt(f32x16& p0, f32x16& p1, const char* K_lds, int r32, int hi, const bf16x8* qr, const ALAS float* kbt) {
#pragma unroll
    for (int g = 0; g < 4; ++g) { const f32x4 a = *(const ALAS f32x4*)(kbt + 8 * g), b = *(const ALAS f32x4*)(kbt + 32 + 8 * g);
        p0[4 * g] = a[0]; p0[4 * g + 1] = a[1]; p0[4 * g + 2] = a[2]; p0[4 * g + 3] = a[3];
        p1[4 * g] = b[0]; p1[4 * g + 1] = b[1]; p1[4 * g + 2] = b[2]; p1[4 * g + 3] = b[3]; }
    const char* kb[4];
#pragma unroll
    for (int dd = 0; dd < 4; ++dd) kb[dd] = K_lds + KB * SHM_K + KSWZ(r32, (dd * 16 + hi * 8) * 2);
#pragma unroll
    for (int d0 = 0; d0 < 8; ++d0) { const char* a = kb[d0 & 3] + (d0 >> 2) * 128;
        bf16x8 b0 = *reinterpret_cast<const bf16x8*>(a);
        bf16x8 b1 = *reinterpret_cast<const bf16x8*>(a + 32 * 256);
        p0 = __builtin_amdgcn_mfma_f32_32x32x16_bf16(b0, qr[d0], p0, 0, 0, 0);
        p1 = __builtin_amdgcn_mfma_f32_32x32x16_bf16(b1, qr[d0], p1, 0, 0, 0); }
}
template <int VB, bool SK>
__device__ __forceinline__ void pv_tile(f32x16* o, int vb0, bf16x8 pa0, bf16x8 pa1, bf16x8 pa2, bf16x8 pa3, bool act) {
    if (SK && !act) return;
#define TRRD(dst, off) asm volatile("ds_read_b64_tr_b16 %0, %1 offset:%2" : "=&v"(dst) : "v"(vb0), "i"(off) : "memory")
#define PV_D0(d0) do { s16x4 l0, l1, l2, l3, h0, h1, h2, h3; constexpr int b_ = VB * SHM_V + v_rd_off(d0, 0, 0);     \
        TRRD(l0, b_); TRRD(h0, b_ + 2048); TRRD(l1, b_ + 4096); TRRD(h1, b_ + 6144); TRRD(l2, b_ + 8192); TRRD(h2, b_ + 10240); TRRD(l3, b_ + 12288); TRRD(h3, b_ + 14336); \
        asm volatile("s_waitcnt lgkmcnt(0)" ::: "memory"); SBAR();                 \
        o[d0] = __builtin_amdgcn_mfma_f32_32x32x16_bf16(pa0, (bf16x8){l0[0], l0[1], l0[2], l0[3], h0[0], h0[1], h0[2], h0[3]}, o[d0], 0, 0, 0);   \
        o[d0] = __builtin_amdgcn_mfma_f32_32x32x16_bf16(pa1, (bf16x8){l1[0], l1[1], l1[2], l1[3], h1[0], h1[1], h1[2], h1[3]}, o[d0], 0, 0, 0);   \
        o[d0] = __builtin_amdgcn_mfma_f32_32x32x16_bf16(pa2, (bf16x8){l2[0], l2[1], l2[2], l2[3], h2[0], h2[1], h2[2], h2[3]}, o[d0], 0, 0, 0);   \
        o[d0] = __builtin_amdgcn_mfma_f32_32x32x16_bf16(pa3, (bf16x8){l3[0], l3[1], l3[2], l3[3], h3[0], h3[1], h3[2], h3[3]}, o[d0], 0, 0, 0); } while (0)
    PV_D0(0); PV_D0(1); PV_D0(2); PV_D0(3);
#undef PV_D0
#undef TRRD
}

struct BlockRef { const bf16* Q; const bf16* K; const bf16* V; bf16* O; const bf16* GA; const bf16* OB; int P0; int jlo; int bh; };
struct Seam { bf16x8 qr[8]; bf16x8 st_v0, st_v1, st_k0, st_k1; };
#define VMW() asm volatile("s_waitcnt vmcnt(0)" ::: "memory")
#define VMWN(n) asm volatile("s_waitcnt vmcnt(%0)" :: "i"(n) : "memory")
#define SLOAD_H(Kp, Vp, k0) do { const bf16* kt_ = (Kp) + (size_t)(k0) * RS; const bf16* vt_ = (Vp) + (size_t)(k0) * RS;                      \
                         S.st_v0 = load8<bf16>(vt_ + kvo0); S.st_v1 = load8<bf16>(vt_ + kvo1);                                       \
                         S.st_k0 = load8<bf16>(kt_ + kvo0); S.st_k1 = load8<bf16>(kt_ + kvo1); } while (0)
#define SWRITE_HK(bf) do { *(bf16x8*)(K_lds + (bf) * SHM_K + kws) = S.st_k0; *(bf16x8*)(K_lds + (bf) * SHM_K + kws + 32 * 256) = S.st_k1; } while (0)
#define SWRITE_HV(bf) do { *(bf16x8*)(V_lds + (bf) * SHM_V + vst0) = S.st_v0; *(bf16x8*)(V_lds + (bf) * SHM_V + vst1) = S.st_v1; } while (0)
#define SWRITE_H(bf) do { SWRITE_HV(bf); SWRITE_HK(bf); } while (0)
__device__ __forceinline__ void fox_prime(const BlockRef& cur, char* lds, Seam& S, int wave_s) {
    int tid = 0; asm volatile("" : "+v"(tid)); tid = wave_s * 64 + (int)__builtin_amdgcn_mbcnt_hi(~0u, __builtin_amdgcn_mbcnt_lo(~0u, (unsigned)tid)); asm volatile("" : "+v"(tid));
    const int wid = __builtin_amdgcn_readfirstlane(tid >> 6), lane = tid & 63, r32 = lane & 31, hi = lane >> 5;
    const int sr = tid >> 4, sc = (tid & 15) * 8, kws = KSWZ(sr, sc * 2); char* K_lds = lds + 2 * SHM_V;
    const unsigned kvo0 = (unsigned)(sr * RS + sc), kvo1 = kvo0 + 32u * RS, qo = (unsigned)(r32 * RS + hi * 8);
    { const bf16* qb_ = cur.Q + (size_t)(wid * QBLK) * RS;
#pragma unroll
    for (int d0 = 0; d0 < 8; ++d0) S.qr[d0] = load8<bf16>(qb_ + qo + d0 * 16); }
    SLOAD_H(cur.K, cur.V, cur.jlo * KVBLK); VMW(); SWRITE_HK(0);
    __syncthreads();
}
constexpr int CW_QCTR = 3584, CW_NRM = 3616;
constexpr float FOX_L = 40.0f;
struct FoxCtx { unsigned short* Qb; const unsigned short* Kb; const unsigned short* Vb; const unsigned short* GAb; const unsigned short* OBb; const float* kbias; unsigned* ctl; volatile ALAS unsigned* slot; };
__device__ __forceinline__ BlockRef fox_mkref(int n, const FoxCtx& cx, int lane) {
    unsigned short* Qb = cx.Qb; const unsigned short* Kb = cx.Kb; const unsigned short* Vb = cx.Vb; const unsigned short* GAb = cx.GAb; const unsigned short* OBb = cx.OBb; const float* kbias = cx.kbias; const unsigned* ctl = cx.ctl;
    const int bh = n & 31, qb = 31 - (n >> 5), b = bh >> 3, h = bh & 7;
    const size_t qo = ((size_t)b * 8192 + (size_t)qb * 256) * RS + h * 128, ko = (size_t)b * 8192 * RS + h * 128;
    BlockRef r; r.Q = (const bf16*)(Qb + qo); r.O = (bf16*)(Qb + qo); r.K = (const bf16*)(Kb + ko); r.V = (const bf16*)(Vb + ko);
    r.GA = (const bf16*)(GAb + qo); r.OB = (const bf16*)(OBb + qo); r.P0 = qb * 256; r.bh = bh;
    const float* kbg = kbias + (size_t)bh * 8192; const int nt0 = r.P0 >> 6;
    const float kb0 = kbg[r.P0], ka = kbg[64 * lane + 63], kb_ = kbg[64 * (lane + 64) + 63];
    f32x4 qv_, kv_;
    { const unsigned* np_ = ctl + CW_NRM + bh * 8;
      asm volatile("global_load_dwordx4 %0, %2, off sc0 sc1\n\tglobal_load_dwordx4 %1, %2, off offset:16 sc0 sc1\n\ts_waitcnt vmcnt(0)" : "=&v"(qv_), "=&v"(kv_) : "v"(np_) : "memory"); }
    const float qn2 = (qv_.x + qv_.y) + (qv_.z + qv_.w), kn2 = (kv_.x + kv_.y) + (kv_.z + kv_.w);
    const float thr = FOX_L * 11.313708498984761f + 2.05f * sqrtf(qn2 * kn2);
    const int cnt = __popcll(__ballot(lane < nt0 && (kb0 - ka) > thr)) + __popcll(__ballot(lane + 64 < nt0 && (kb0 - kb_) > thr));
    r.jlo = __builtin_amdgcn_readfirstlane(cnt);
    return r;
}
__device__ __forceinline__ unsigned fox_fetch(unsigned* ctl) { return __hip_atomic_fetch_add(ctl + CW_QCTR, 1u, __ATOMIC_RELAXED, __HIP_MEMORY_SCOPE_AGENT); }
__device__ __forceinline__ void fox_block(const BlockRef& cur, BlockRef& nxt, bool& last, const FoxCtx& cx, char* lds, const ALAS float* kbl, Seam& S, int wave_s) {
    int tid = 0; asm volatile("" : "+v"(tid)); tid = wave_s * 64 + (int)__builtin_amdgcn_mbcnt_hi(~0u, __builtin_amdgcn_mbcnt_lo(~0u, (unsigned)tid)); asm volatile("" : "+v"(tid));
    const int wid = __builtin_amdgcn_readfirstlane(tid >> 6), lane = tid & 63, r32 = lane & 31, hi = lane >> 5;
    constexpr int W = 1 << 30; constexpr bool SK = false;
    const int j_lo = cur.jlo, NT = (cur.P0 + QB - 1) / KVBLK + 1 - j_lo;
    const int qlo = cur.P0 + wid * QBLK, qm = qlo + r32 - 4 * hi;
    char* V_lds = lds; char* K_lds = lds + 2 * SHM_V;
    float* ws = (float*)(lds + 2 * SHM_V + 2 * SHM_K) + wid * 64; float* li_l = ws, * al_l = ws + 32;
    float m_reg = -1e30f, l_reg = 0; f32x16 o[4] = {};
    const int sr = tid >> 4, sc = (tid & 15) * 8, vst0 = v_st(sr, sc), vst1 = v_st(32 + sr, sc), kws = KSWZ(sr, sc * 2);
    const int vb0 = (int)(uintptr_t)V_lds + v_rd_base(lane);
    const unsigned kvo0 = (unsigned)(sr * RS + sc), kvo1 = kvo0 + 32u * RS, qo = (unsigned)(r32 * RS + hi * 8);
    const bf16* Kh = cur.K; const bf16* Vh = cur.V;
    const ALAS float* kbh = kbl + 4 * hi;
#define RESC(a) do { if (__any((a) < 1.f)) { if (hi == 0) al_l[r32] = (a); asm volatile("s_waitcnt lgkmcnt(0)" ::: "memory");              \
                     for (int d_ = 0; d_ < 4; ++d_) for (int r = 0; r < 16; ++r) o[d_][r] *= al_l[crow(r, hi)]; } } while (0)
#define KBASE(t) ((j_lo + (t)) * KVBLK)
#define MASKT(P0_, P1_, t) do { const int kb_ = KBASE(t); if (kb_ + KVBLK - 1 > qlo) mask_tile(P0_, P1_, qm - kb_, (unsigned)W); } while (0)
    constexpr int NQL = 8;
#define SEAM_K0() do { VMWN(NQL); SWRITE_HK(0); SBAR(); } while (0)
    f32x16 pA0, pA1, pB0, pB1; float mnA, mnB, alA, alB; bf16x8 pa0, pa1, pa2, pa3;
    SWRITE_HV(0); SBAR();
    if (NT > 1) { SLOAD_H(Kh, Vh, KBASE(1)); }
    SBAR(); qkt<0>(pA0, pA1, K_lds, r32, hi, S.qr, kbh + KBASE(0));
    MASKT(pA0, pA1, 0); partialSM(pA0, pA1, m_reg, mnA, alA);
    if (NT > 1) { VMW(); SWRITE_H(1); }
    __syncthreads();
#define HALF_STEP(PX0, PX1, mnX, alX, PY0, PY1, alY, t, KB, VB, SB) do {                                                      \
        SBAR(); qkt<KB>(PX0, PX1, K_lds, r32, hi, S.qr, kbh + KBASE(t));                                                      \
        finishSM(PY0, PY1, alY, l_reg, pa0, pa1, pa2, pa3); SBAR();                                                           \
        if ((t) + 1 < NT) { SLOAD_H(Kh, Vh, KBASE((t) + 1)); SBAR(); }                                                        \
        pv_tile<VB, SK>(o, vb0, pa0, pa1, pa2, pa3, true); MASKT(PX0, PX1, (t)); partialSM(PX0, PX1, m_reg, mnX, alX);         \
        __syncthreads();                                                                                                      \
        if ((t) + 1 < NT) { VMW(); SWRITE_H(SB); }                                                                            \
        RESC(alX); __syncthreads(); } while (0)
    const int tf = NT >= 8 ? ((NT - 5) | 1) : -1;
    if (tf < 0 && tid == 0) cx.slot[0] = fox_fetch(cx.ctl);
    for (int t = 1; t + 1 < NT; t += 2) {
        if (t == tf && tid == 0) cx.slot[0] = fox_fetch(cx.ctl);
        HALF_STEP(pB0, pB1, mnB, alB, pA0, pA1, alA, t, 1, 0, 0);
        HALF_STEP(pA0, pA1, mnA, alA, pB0, pB1, alB, t + 1, 0, 1, 1);
    }
    const bool even = (NT & 1) == 0;
    if (even) { SBAR(); qkt<1>(pB0, pB1, K_lds, r32, hi, S.qr, kbh + KBASE(NT - 1)); SBAR(); }
    { const int n_nxt = __builtin_amdgcn_readfirstlane((int)cx.slot[0]);
      last = n_nxt >= 1024; if (last) nxt = cur; else nxt = fox_mkref(n_nxt, cx, lane); }
    SBAR();
    SLOAD_H(nxt.K, nxt.V, nxt.jlo * KVBLK); SBAR();
    { const bf16* qb_ = nxt.Q + (size_t)(wid * QBLK) * RS;
#pragma unroll
    for (int d0 = 0; d0 < 8; ++d0) S.qr[d0] = load8<bf16>(qb_ + qo + d0 * 16); }
    SBAR();
    finishSM(pA0, pA1, alA, l_reg, pa0, pa1, pa2, pa3); SBAR();
    pv_tile<0, SK>(o, vb0, pa0, pa1, pa2, pa3, true);
    if (even) { MASKT(pB0, pB1, NT - 1); partialSM(pB0, pB1, m_reg, mnB, alB); __syncthreads(); RESC(alB);
        finishSM(pB0, pB1, alB, l_reg, pa0, pa1, pa2, pa3); SBAR(); pv_tile<1, SK>(o, vb0, pa0, pa1, pa2, pa3, true); }
    SBAR(); SEAM_K0();
    if (hi == 0) li_l[r32] = l_reg; asm volatile("s_waitcnt lgkmcnt(0)" ::: "memory");
    float rli[16];
#pragma unroll
    for (int r = 0; r < 16; ++r) rli[r] = __builtin_amdgcn_rcpf(li_l[crow(r, hi)]);
    const size_t wofs = (size_t)(wid * QBLK) * RS; const bf16* gab = cur.GA + wofs; const bf16* obb = cur.OB + wofs; bf16* oub = cur.O + wofs;
    const unsigned eo = (unsigned)(hi * 4 * RS + r32);
    unsigned gav[2][2][4], obv[2][2][4];
#define EPI_LOAD(rg_) do { _Pragma("unroll") for (int rr = 0; rr < 2; ++rr) _Pragma("unroll") for (int d0 = 0; d0 < 4; ++d0) { const int r = (rg_) * 2 + rr, co = ((r & 3) + 8 * (r >> 2)) * RS + d0 * 32; \
        gav[(rg_) & 1][rr][d0] = ((const unsigned short*)(gab + co))[eo]; obv[(rg_) & 1][rr][d0] = ((const unsigned short*)(obb + co))[eo]; } } while (0)
    EPI_LOAD(0);
#pragma unroll
    for (int rg = 0; rg < 8; ++rg) {
        if (rg < 7) EPI_LOAD(rg + 1);
        SBAR();
#pragma unroll
        for (int rr = 0; rr < 2; ++rr)
#pragma unroll
            for (int d0 = 0; d0 < 4; ++d0) { const int r = rg * 2 + rr, co = ((r & 3) + 8 * (r >> 2)) * RS + d0 * 32;
                const float v = o[d0][r] * rli[r];
                const float m = __uint_as_float(gav[rg & 1][rr][d0] << 16) * v + __uint_as_float(obv[rg & 1][rr][d0] << 16);
                ((unsigned short*)(oub + co))[eo] = (unsigned short)(cvtpk(m, 0.f) & 0xffffu); }
        SBAR(); }
#undef EPI_LOAD
    __syncthreads();
#undef RESC
#undef KBASE
#undef MASKT
#undef SEAM_K0
#undef HALF_STEP
}
#undef ROW
#undef VMW
#undef VMWN
#undef SLOAD_H
#undef SWRITE_HK
#undef SWRITE_HV
#undef SWRITE_H
#undef SBAR
#undef KSWZ
}

#define LAS __attribute__((address_space(3)))
typedef unsigned short bf16u;
typedef unsigned v4u __attribute__((ext_vector_type(4)));
typedef float v4f __attribute__((ext_vector_type(4)));
typedef short v8s __attribute__((ext_vector_type(8)));
typedef float v16f __attribute__((ext_vector_type(16)));

constexpr int T = 32768, DM = 1024, FF = 4096, SEQ = 8192, NH = 8, INW = 7176;
constexpr float RMS_EPS = 1e-6f, LN_EPS = 1e-5f;
constexpr size_t MiB = 1u << 20;
constexpr size_t WS_RSTD0 = 0, WS_RSTD1 = 128 * 1024, WS_RSTD2 = 256 * 1024, WS_WF = 384 * 1024, WS_WSM = 512 * 1024, WS_LOGF = 1 * MiB, WS_KBIAS = 2 * MiB, WS_BAR = 3 * MiB, BAR_BYTES = 16384;
constexpr size_t WS_WGU1 = 4 * MiB, WS_WD1 = 20 * MiB, WS_WIN = 28 * MiB, WS_WOUT = 42 * MiB, WS_WGU2 = 44 * MiB, WS_WD2 = 60 * MiB;
constexpr size_t WS_R0 = 68 * MiB, WS_S0 = 132 * MiB, WS_S1 = 196 * MiB, WS_S2 = 260 * MiB, WS_S3 = 324 * MiB, WS_S4 = 388 * MiB, WS_END = 452 * MiB;
constexpr int LDS_TOTAL = 140 * 1024, LDS_MISC = 136 * 1024;

__device__ __forceinline__ unsigned f2bf(float f) { unsigned u = __builtin_bit_cast(unsigned, f); return (u + 0x7fffu + ((u >> 16) & 1u)) >> 16; }
__device__ __forceinline__ unsigned pk2(float lo, float hi) { return f2bf(lo) | (f2bf(hi) << 16); }
__device__ __forceinline__ float bflo(unsigned w) { return __uint_as_float(w << 16); }
__device__ __forceinline__ float bfhi(unsigned w) { return __uint_as_float(w & 0xffff0000u); }
template <int X> __device__ __forceinline__ float swz_xor(float v) { return __int_as_float(__builtin_amdgcn_ds_swizzle(__float_as_int(v), (X << 10) | 0x1f)); }
template <int CTRL> __device__ __forceinline__ float dpp_f(float v) { return __int_as_float(__builtin_amdgcn_update_dpp(0, __float_as_int(v), CTRL, 0xf, 0xf, false)); }
__device__ __forceinline__ float wave_sum(float v) {
    v += dpp_f<0xB1>(v); v += dpp_f<0x4E>(v); v += dpp_f<0x141>(v); v += dpp_f<0x140>(v); v += swz_xor<16>(v);
    auto rr = __builtin_amdgcn_permlane32_swap(__float_as_uint(v), __float_as_uint(v), false, false);
    return __uint_as_float(rr[0]) + __uint_as_float(rr[1]);
}

#define CAS __attribute__((address_space(4)))
#define XB_TMO      128
#define XB_XCNT(j)  (256  + 64 * (j))
#define XB_XSUB(j)  (1280 + 64 * (j))
#define XB_XGEN(j)  (2304 + 64 * (j))
#define XB_TOP      3328
#define XB_TOPGEN   3392
#define XCD_BAR_WORDS 3456
#define XB_SPIN_CAP (1u << 18)

__device__ __forceinline__ unsigned xb_ld(unsigned* p)              { return __hip_atomic_load(p, __ATOMIC_RELAXED, __HIP_MEMORY_SCOPE_AGENT); }
__device__ __forceinline__ unsigned xb_add(unsigned* p, unsigned v) { return __hip_atomic_fetch_add(p, v, __ATOMIC_RELAXED, __HIP_MEMORY_SCOPE_AGENT); }
__device__ __forceinline__ unsigned xb_xcc_id() { return (unsigned)__builtin_amdgcn_s_getreg((3 << 11) | 20) & 0xFu; }
#define XB_SPIN(cond, bar) do { unsigned _sp = 0; while (cond) { __builtin_amdgcn_s_sleep(1); \
    if ((++_sp & 255u) == 0u) { if (xb_ld(&(bar)[XB_TMO])) break; if (_sp > XB_SPIN_CAP) { atomicAdd(&(bar)[XB_TMO], 1u); break; } } } } while (0)

__device__ __forceinline__ void xcd_barrier_complete(unsigned* bar, unsigned x, unsigned& nloc, unsigned& nx) {
    const unsigned G = gridDim.x * gridDim.y * gridDim.z;
    unsigned sum, cnt, mine, sp = 0u;
    for (;;) {
        sum = 0u; cnt = 0u; mine = 0u;
#pragma unroll
        for (unsigned j = 0; j < 16; ++j) { const unsigned c = xb_ld(&bar[XB_XCNT(j)]); sum += c; cnt += (c > 0u) ? 1u : 0u; mine = (j == x) ? c : mine; }
        if (sum == G) break;
        __builtin_amdgcn_s_sleep(1);
        if ((++sp & 255u) == 0u) { if (xb_ld(&bar[XB_TMO])) break; if (sp > XB_SPIN_CAP) { atomicAdd(&bar[XB_TMO], 1u); break; } }
    }
    nloc = mine > 0u ? mine : 1u; nx = cnt > 0u ? cnt : 1u;
}
__device__ __forceinline__ void xcd_barrier(unsigned* bar, volatile LAS unsigned* st, bool leader) {
    asm volatile("s_waitcnt vmcnt(0)" ::: "memory");
    __syncthreads();
    if (leader) {
        const unsigned x = xb_xcc_id();
        __builtin_amdgcn_s_waitcnt(0);
        unsigned nloc = st[0], nx = st[1];
        if (nloc == 0u) { xcd_barrier_complete(bar, x, nloc, nx); st[0] = nloc; st[1] = nx; }
        const unsigned old = xb_add(&bar[XB_XSUB(x)], 1u);
        const unsigned gen = old / nloc;
        if (old + 1u == (gen + 1u) * nloc) {
            __builtin_amdgcn_fence(__ATOMIC_RELEASE, "agent");
            asm volatile("s_waitcnt vmcnt(0)" ::: "memory");
            const unsigned og = xb_add(&bar[XB_TOP], 1u);
            const unsigned tg = og / nx;
            if (og + 1u == (tg + 1u) * nx) xb_add(&bar[XB_TOPGEN], 1u);
            else XB_SPIN(xb_ld(&bar[XB_TOPGEN]) == tg, bar);
            __builtin_amdgcn_fence(__ATOMIC_ACQUIRE, "agent");
            xb_add(&bar[XB_XGEN(x)], 1u);
            asm volatile("s_waitcnt vmcnt(0)" ::: "memory");
        } else {
            XB_SPIN(xb_ld(&bar[XB_XGEN(x)]) == gen, bar);
            __builtin_amdgcn_fence(__ATOMIC_ACQUIRE, "agent");
            asm volatile("s_waitcnt vmcnt(0)" ::: "memory");
        }
    }
    __syncthreads();
}

struct Params {
    const float* x; const float* f1_pre_g; const float* f1_wg; const float* f1_wu; const float* f1_wd; const float* f1_post_g;
    const float* mix_pre_g; const float* w_in; const float* b_forget; const float* ln_g; const float* ln_b; const float* w_s; const float* b_s;
    const float* w_out; const float* mix_post_g; const float* f2_pre_g; const float* f2_wg; const float* f2_wu; const float* f2_wd; const float* f2_post_g;
    float* out; unsigned char* ws;
};

__device__ __forceinline__ void tr_item(const float* __restrict__ W, int ldn, int K, int scol, bf16u* WT, int drow, const float* __restrict__ g, LAS float* scr, int k0, int lane) {
    float v[32];
    const float* src = W + (size_t)(k0 + (lane >> 5)) * ldn + scol + (lane & 31);
#pragma unroll
    for (int i = 0; i < 32; ++i) v[i] = __builtin_nontemporal_load(src + (size_t)(2 * i) * ldn);
    const int c = lane & 7;
    v4f g0 = (v4f){1.f, 1.f, 1.f, 1.f}, g1 = g0;
    if (g) { g0 = *(const v4f*)(g + k0 + 8 * c); g1 = *(const v4f*)(g + k0 + 8 * c + 4); }
#pragma unroll
    for (int i = 0; i < 32; ++i) scr[(2 * i + (lane >> 5)) * 33 + (lane & 31)] = v[i];
    asm volatile("s_waitcnt lgkmcnt(0)" ::: "memory");
#pragma unroll
    for (int j = 0; j < 4; ++j) { const int n = (lane >> 3) + 8 * j; const LAS float* s = scr + (8 * c) * 33 + n;
        v4u o; o.x = pk2(s[0 * 33] * g0.x, s[1 * 33] * g0.y); o.y = pk2(s[2 * 33] * g0.z, s[3 * 33] * g0.w); o.z = pk2(s[4 * 33] * g1.x, s[5 * 33] * g1.y); o.w = pk2(s[6 * 33] * g1.z, s[7 * 33] * g1.w);
        *(v4u*)(WT + (size_t)(drow + n) * K + k0 + 8 * c) = o; }
    asm volatile("s_waitcnt lgkmcnt(0)" ::: "memory");
}

typedef const CAS Params* PP;
__device__ __forceinline__ int fresh_tid(int wave_s) { int t = 0; asm volatile("" : "+v"(t)); t = wave_s * 64 + (int)__builtin_amdgcn_mbcnt_hi(~0u, __builtin_amdgcn_mbcnt_lo(~0u, (unsigned)t)); asm volatile("" : "+v"(t)); return t;     }
__device__ __forceinline__ void p0_prologue(PP p, LAS unsigned char* lds, int gw, int NGW, int lane, int wave, int gtid, int NGT) {
    unsigned char* ws = p->ws;
    LAS float* scr = (LAS float*)(lds + wave * 16384);
    constexpr int I_G = 16 * 128, I_D = 64 * 32, I_IN = 16 * 224, I_O = 16 * 32;
    constexpr int NITEMS = 2 * (2 * I_G + I_D) + I_IN + I_O;
    for (int it = gw; it < NITEMS; it += NGW) {
        int r = it;
        if (r < 2 * I_G) { const bool up = r >= I_G; if (up) r -= I_G; const int kb = r >> 7, nb = r & 127, n0 = nb * 32;
            tr_item(up ? p->f1_wu : p->f1_wg, FF, DM, n0, (bf16u*)(ws + WS_WGU1), (n0 >> 7) * 256 + (n0 & 127) + (up ? 128 : 0), p->f1_pre_g, scr, kb * 64, lane); continue; }
        r -= 2 * I_G;
        if (r < I_D) { const int kb = r >> 5, nb = r & 31; tr_item(p->f1_wd, DM, FF, nb * 32, (bf16u*)(ws + WS_WD1), nb * 32, nullptr, scr, kb * 64, lane); continue; }
        r -= I_D;
        if (r < I_IN) { const int kb = r / 224, nb = r % 224, d0 = nb * 32;
            const int sc = d0 < 2048 ? d0 + 1024 : d0 < 3072 ? d0 - 2048 : d0 < 4096 ? 5128 + (d0 - 3072) : d0 < 5120 ? 3080 + (d0 - 4096) : d0 < 6144 ? 4104 + (d0 - 5120) : 6152 + (d0 - 6144);
            tr_item(p->w_in, INW, DM, sc, (bf16u*)(ws + WS_WIN), d0, p->mix_pre_g, scr, kb * 64, lane); continue; }
        r -= I_IN;
        if (r < I_O) { const int kb = r >> 5, nb = r & 31; tr_item(p->w_out, DM, DM, nb * 32, (bf16u*)(ws + WS_WOUT), nb * 32, nullptr, scr, kb * 64, lane); continue; }
        r -= I_O;
        if (r < 2 * I_G) { const bool up = r >= I_G; if (up) r -= I_G; const int kb = r >> 7, nb = r & 127, n0 = nb * 32;
            tr_item(up ? p->f2_wu : p->f2_wg, FF, DM, n0, (bf16u*)(ws + WS_WGU2), (n0 >> 7) * 256 + (n0 & 127) + (up ? 128 : 0), p->f2_pre_g, scr, kb * 64, lane); continue; }
        r -= 2 * I_G;
        { const int kb = r >> 5, nb = r & 31; tr_item(p->f2_wd, DM, FF, nb * 32, (bf16u*)(ws + WS_WD2), nb * 32, nullptr, scr, kb * 64, lane); }
    }
    float* Wf = (float*)(ws + WS_WF);
    for (int i = gtid; i < 8 * DM; i += NGT) { const int h = i >> 10, k = i & 1023; Wf[i] = p->w_in[(size_t)k * INW + 3072 + h] * p->mix_pre_g[k]; }
    bf16u* Wsm = (bf16u*)(ws + WS_WSM);
    for (int i = gtid; i < 8 * 128 * 128; i += NGT) { const int t = (i >> 7) & 127, s = i & 127; Wsm[i] = (bf16u)((s >> 6) <= (t >> 6) ? f2bf(p->w_s[i]) : 0u); }
    bf16u* xb = (bf16u*)(ws + WS_R0); float* rstd0 = (float*)(ws + WS_RSTD0);
    { v4f xv[2][4];
#define P0_LOAD(row0_) do { _Pragma("unroll") for (int n = 0; n < 2; ++n) { const float* xr_ = p->x + (size_t)((row0_) + n * NGW) * DM + 8 * lane; _Pragma("unroll") for (int j = 0; j < 2; ++j) { xv[n][2 * j] = __builtin_nontemporal_load((const v4f*)(xr_ + 512 * j)); xv[n][2 * j + 1] = __builtin_nontemporal_load((const v4f*)(xr_ + 512 * j + 4)); } } } while (0)
      if (gw < T) P0_LOAD(gw);
      for (int row = gw; row < T; row += 2 * NGW) {
        v4f v[2][4]; float ss[2];
#pragma unroll
        for (int n = 0; n < 2; ++n) { float s = 0.f;
#pragma unroll
            for (int j = 0; j < 4; ++j) { v[n][j] = xv[n][j]; s += (v[n][j].x * v[n][j].x + v[n][j].y * v[n][j].y) + (v[n][j].z * v[n][j].z + v[n][j].w * v[n][j].w); }
            ss[n] = s; }
        if (row + 2 * NGW < T) P0_LOAD(row + 2 * NGW);
#pragma unroll
        for (int n = 0; n < 2; ++n) ss[n] = wave_sum(ss[n]);
#pragma unroll
        for (int n = 0; n < 2; ++n) { const int rw = row + n * NGW;
            if (lane == 0) rstd0[rw] = 1.0f / sqrtf(ss[n] * (1.0f / DM) + RMS_EPS);
#pragma unroll
            for (int j = 0; j < 2; ++j) { v4u o; o.x = pk2(v[n][2 * j].x, v[n][2 * j].y); o.y = pk2(v[n][2 * j].z, v[n][2 * j].w); o.z = pk2(v[n][2 * j + 1].x, v[n][2 * j + 1].y); o.w = pk2(v[n][2 * j + 1].z, v[n][2 * j + 1].w);
                *(v4u*)(xb + (size_t)rw * DM + 8 * lane + 512 * j) = o; } }
      }
#undef P0_LOAD
    }
}

template <int NR> __device__ __forceinline__ void row_pass(const float* res, const bf16u* resb, const bf16u* y, const float* __restrict__ gpost, float alpha, float* xout, bf16u* xbo, float* rstd_out,
                                         const LAS float* Wf_l, const float* b_forget, float* logf, int gw, int NGW, int lane) {
    v4f g[4];
#pragma unroll
    for (int j = 0; j < 2; ++j) { g[2 * j] = *(const v4f*)(gpost + 8 * lane + 512 * j); g[2 * j + 1] = *(const v4f*)(gpost + 8 * lane + 512 * j + 4); }
    v4u yw[NR][2], qw[NR][2]; v4f rf[NR][4];
#define RP_LOAD(row0_) do { _Pragma("unroll") for (int n = 0; n < NR; ++n) { const size_t ro_ = (size_t)((row0_) + n * NGW) * DM + 8 * lane; _Pragma("unroll") for (int j = 0; j < 2; ++j) { yw[n][j] = *(const v4u*)(y + ro_ + 512 * j); \
        if (res) { rf[n][2 * j] = __builtin_nontemporal_load((const v4f*)(res + ro_ + 512 * j)); rf[n][2 * j + 1] = __builtin_nontemporal_load((const v4f*)(res + ro_ + 512 * j + 4)); } else qw[n][j] = *(const v4u*)(resb + ro_ + 512 * j); } } } while (0)
    if (gw < T) RP_LOAD(gw);
    for (int row = gw; row < T; row += NR * NGW) {
        v4f r[NR][4], yv[NR][4];
#pragma unroll
        for (int n = 0; n < NR; ++n)
#pragma unroll
            for (int j = 0; j < 2; ++j) { const v4u w = yw[n][j]; yv[n][2 * j] = (v4f){bflo(w.x), bfhi(w.x), bflo(w.y), bfhi(w.y)}; yv[n][2 * j + 1] = (v4f){bflo(w.z), bfhi(w.z), bflo(w.w), bfhi(w.w)};
                if (res) { r[n][2 * j] = rf[n][2 * j]; r[n][2 * j + 1] = rf[n][2 * j + 1]; }
                else { const v4u q = qw[n][j]; r[n][2 * j] = (v4f){bflo(q.x), bfhi(q.x), bflo(q.y), bfhi(q.y)}; r[n][2 * j + 1] = (v4f){bflo(q.z), bfhi(q.z), bflo(q.w), bfhi(q.w)}; } }
        if (row + NR * NGW < T) RP_LOAD(row + NR * NGW);
        float ss[NR];
#pragma unroll
        for (int n = 0; n < NR; ++n) { float s = 0.f;
#pragma unroll
            for (int j = 0; j < 4; ++j) s += (yv[n][j].x * yv[n][j].x + yv[n][j].y * yv[n][j].y) + (yv[n][j].z * yv[n][j].z + yv[n][j].w * yv[n][j].w);
            ss[n] = s; }
#pragma unroll
        for (int n = 0; n < NR; ++n) ss[n] = wave_sum(ss[n]);
#pragma unroll
        for (int n = 0; n < NR; ++n) { const float sc = alpha / sqrtf(ss[n] * (1.0f / DM) + RMS_EPS);
#pragma unroll
            for (int j = 0; j < 4; ++j) r[n][j] = r[n][j] + (yv[n][j] * sc) * g[j]; }
        if (xout) {
#pragma unroll
            for (int n = 0; n < NR; ++n) { const size_t ro = (size_t)(row + n * NGW) * DM + 8 * lane;
#pragma unroll
                for (int j = 0; j < 2; ++j) { __builtin_nontemporal_store(r[n][2 * j], (v4f*)(xout + ro + 512 * j)); __builtin_nontemporal_store(r[n][2 * j + 1], (v4f*)(xout + ro + 512 * j + 4)); } } }
        if (xbo) {
            float s2[NR], rs[NR];
#pragma unroll
            for (int n = 0; n < NR; ++n) { float s = 0.f;
#pragma unroll
                for (int j = 0; j < 4; ++j) s += (r[n][j].x * r[n][j].x + r[n][j].y * r[n][j].y) + (r[n][j].z * r[n][j].z + r[n][j].w * r[n][j].w);
                s2[n] = s; }
#pragma unroll
            for (int n = 0; n < NR; ++n) s2[n] = wave_sum(s2[n]);
#pragma unroll
            for (int n = 0; n < NR; ++n) { rs[n] = 1.0f / sqrtf(s2[n] * (1.0f / DM) + RMS_EPS); const size_t ro = (size_t)(row + n * NGW) * DM + 8 * lane;
                if (lane == 0) rstd_out[row + n * NGW] = rs[n];
#pragma unroll
                for (int j = 0; j < 2; ++j) { v4u o; o.x = pk2(r[n][2 * j].x, r[n][2 * j].y); o.y = pk2(r[n][2 * j].z, r[n][2 * j].w); o.z = pk2(r[n][2 * j + 1].x, r[n][2 * j + 1].y); o.w = pk2(r[n][2 * j + 1].z, r[n][2 * j + 1].w);
                    *(v4u*)(xbo + ro + 512 * j) = o; } }
            if (logf) {
#pragma unroll
                for (int n = 0; n < NR; ++n) {
                    float d8[8];
#pragma unroll
                    for (int h = 0; h < 8; ++h) { const LAS float* wf = Wf_l + h * DM + 8 * lane; float d = 0.f;
#pragma unroll
                        for (int j = 0; j < 2; ++j) { const v4f a = *(const LAS v4f*)(wf + 512 * j), b = *(const LAS v4f*)(wf + 512 * j + 4);
                            d += (r[n][2 * j].x * a.x + r[n][2 * j].y * a.y) + (r[n][2 * j].z * a.z + r[n][2 * j].w * a.w) + (r[n][2 * j + 1].x * b.x + r[n][2 * j + 1].y * b.y) + (r[n][2 * j + 1].z * b.z + r[n][2 * j + 1].w * b.w); }
                        d8[h] = d; }
#pragma unroll
                    for (int h = 0; h < 8; ++h) d8[h] += dpp_f<0xB1>(d8[h]);
#pragma unroll
                    for (int h = 0; h < 8; ++h) d8[h] += dpp_f<0x4E>(d8[h]);
#pragma unroll
                    for (int h = 0; h < 8; ++h) d8[h] += dpp_f<0x141>(d8[h]);
#pragma unroll
                    for (int h = 0; h < 8; ++h) d8[h] += dpp_f<0x140>(d8[h]);
#pragma unroll
                    for (int h = 0; h < 8; ++h) d8[h] += swz_xor<16>(d8[h]);
#pragma unroll
                    for (int h = 0; h < 8; ++h) { auto rr = __builtin_amdgcn_permlane32_swap(__float_as_uint(d8[h]), __float_as_uint(d8[h]), false, false); d8[h] = __uint_as_float(rr[0]) + __uint_as_float(rr[1]); }
                    float dsel = d8[0];
#pragma unroll
                    for (int h = 1; h < 8; ++h) dsel = lane == h ? d8[h] : dsel;
                    if (lane < 8) { const float z = dsel * rs[n] + b_forget[lane]; const float ls = fminf(z, 0.f) - log1pf(expf(-fabsf(z))); logf[(size_t)lane * T + row + n * NGW] = ls; }
                }
            }
        }
    }
}

#undef RP_LOAD
__device__ __forceinline__ void cumsum_phase(const float* logf, float* kbias, LAS unsigned char* lds, int bx, int tid, int lane, int wave) {
    if (bx < 32) {
        const int b = bx >> 3, h = bx & 7; LAS float* wt = (LAS float*)lds;
        float v[16]; float run = 0.f;
#pragma unroll
        for (int i = 0; i < 16; ++i) { run += logf[(size_t)h * T + (size_t)b * SEQ + tid * 16 + i]; v[i] = run; }
        float incl = run;
#pragma unroll
        for (int o = 1; o < 64; o <<= 1) { const float t = __int_as_float(__builtin_amdgcn_ds_bpermute(((lane - o) & 63) << 2, __float_as_int(incl))); if (lane >= o) incl += t; }
        if (lane == 63) wt[wave] = incl;
        __syncthreads();
        float base = incl - run;
        for (int w = 0; w < wave; ++w) base += wt[w];
#pragma unroll
        for (int i = 0; i < 16; ++i) kbias[(size_t)bx * SEQ + tid * 16 + i] = -(base + v[i]) * 11.313708498984761f;
    }
    __syncthreads();
}

__device__ __forceinline__ void sgu_phase(PP p, LAS unsigned char* lds, bf16u* U, const bf16u* SV, const bf16u* GB, const bf16u* Wsm, int G, int bx, int tid, int lane, int wave) {
    LAS bf16u* vnT = (LAS bf16u*)lds;
    const int r32 = lane & 31, hi = lane >> 5;
    for (int unit = bx; unit < 2048; unit += G) {
        const int g = unit & 7, win = unit >> 3; const size_t row0 = (size_t)win * 128; const int col0 = g * 128;
        const int tb = (wave & 3) * 32, cbw = (wave >> 2) * 64;
        unsigned short uu[16][2], gg[16][2]; float bsv[16];
            bf16u* ub = U + (row0 + tb) * DM + col0 + cbw; const bf16u* gbp = GB + (row0 + tb) * DM + col0 + cbw; const float* bsp = p->b_s + g * 128 + tb;
            const unsigned eo = (unsigned)(hi * 4 * DM + r32);
#pragma unroll
            for (int r = 0; r < 16; ++r) { const int tc = (r & 3) + 8 * (r >> 2), co = tc * DM; bsv[r] = bsp[tc + 4 * hi];
                uu[r][0] = (ub + co)[eo]; uu[r][1] = (ub + co + 32)[eo]; gg[r][0] = (gbp + co)[eo]; gg[r][1] = (gbp + co + 32)[eo]; }
        { const int r = tid >> 2, q = tid & 3; const bf16u* src = (SV + row0 * DM + col0) + (unsigned)(r * DM + q * 32);
            float v[32];
#pragma unroll
            for (int i = 0; i < 4; ++i) { const v4u w = *(const v4u*)(src + 8 * i);
                v[8 * i] = bflo(w.x); v[8 * i + 1] = bfhi(w.x); v[8 * i + 2] = bflo(w.y); v[8 * i + 3] = bfhi(w.y); v[8 * i + 4] = bflo(w.z); v[8 * i + 5] = bfhi(w.z); v[8 * i + 6] = bflo(w.w); v[8 * i + 7] = bfhi(w.w); }
            float s = 0.f;
#pragma unroll
            for (int i = 0; i < 32; ++i) s += v[i];
            s += swz_xor<1>(s); s += swz_xor<2>(s);
            const float mu = s * (1.0f / 128.0f); float q2 = 0.f;
#pragma unroll
            for (int i = 0; i < 32; ++i) { v[i] -= mu; q2 += v[i] * v[i]; }
            q2 += swz_xor<1>(q2); q2 += swz_xor<2>(q2);
            const float rs = 1.0f / sqrtf(q2 * (1.0f / 128.0f) + LN_EPS);
            const float* lg = p->ln_g + col0 + q * 32; const float* lb = p->ln_b + col0 + q * 32;
#pragma unroll
            for (int i = 0; i < 32; ++i) vnT[(q * 32 + i) * 136 + r] = (bf16u)f2bf(v[i] * rs * lg[i] + lb[i]);
        }
        v8s afr[8];
        { const bf16u* wa = Wsm + ((size_t)(g * 128 + tb + r32)) * 128 + 8 * hi;
#pragma unroll
          for (int kk = 0; kk < 8; ++kk) afr[kk] = *(const v8s*)(wa + 16 * kk); }
        __syncthreads();
        v16f acc0 = {}, acc1 = {};
        const LAS bf16u* vb0 = vnT + (cbw + r32) * 136 + 8 * hi; const LAS bf16u* vb1 = vb0 + 32 * 136;
#pragma unroll
        for (int kk = 0; kk < 8; ++kk) { const v8s a = afr[kk]; const v8s b0 = *(const LAS v8s*)(vb0 + 16 * kk), b1 = *(const LAS v8s*)(vb1 + 16 * kk);
            acc0 = __builtin_amdgcn_mfma_f32_32x32x16_bf16(a, b0, acc0, 0, 0, 0); acc1 = __builtin_amdgcn_mfma_f32_32x32x16_bf16(a, b1, acc1, 0, 0, 0); }
        {
            __builtin_amdgcn_sched_barrier(0);
#pragma unroll
            for (int r = 0; r < 16; ++r) { const int co = ((r & 3) + 8 * (r >> 2)) * DM;
                const float u0 = __uint_as_float((unsigned)uu[r][0] << 16), u1 = __uint_as_float((unsigned)uu[r][1] << 16), g0 = __uint_as_float((unsigned)gg[r][0] << 16), g1 = __uint_as_float((unsigned)gg[r][1] << 16);
                (ub + co)[eo] = (bf16u)f2bf(g0 * u0 * (acc0[r] + bsv[r])); (ub + co + 32)[eo] = (bf16u)f2bf(g1 * u1 * (acc1[r] + bsv[r])); } }
        __syncthreads();
    }
}

__device__ __forceinline__ void attn_phase(unsigned char* lds_g, LAS unsigned char* lds, bf16u* Qb, const bf16u* Kb, const bf16u* Vb, const bf16u* GAb, const bf16u* OBb, const float* kbias, unsigned* ctl, int wave_s) {
    const LAS float* kbl = (const LAS float*)(lds + att::KB_OFF);
    att::FoxCtx cx; cx.Qb = Qb; cx.Kb = Kb; cx.Vb = Vb; cx.GAb = GAb; cx.OBb = OBb; cx.kbias = kbias; cx.ctl = ctl; cx.slot = (volatile LAS unsigned*)(lds + LDS_MISC + 16);
    int tid = fresh_tid(wave_s);
    if (tid == 0) cx.slot[0] = att::fox_fetch(ctl);
    __syncthreads();
    const int n_cur = __builtin_amdgcn_readfirstlane((int)cx.slot[0]);
    __syncthreads();
    if (n_cur >= 1024) return;
    att::BlockRef cur = att::fox_mkref(n_cur, cx, tid & 63);
    att::Seam S;
    bool first = true;
    for (;;) {
        tid = fresh_tid(wave_s);
        { const float* kbg = kbias + (size_t)cur.bh * SEQ; LAS float* kw = (LAS float*)(lds + att::KB_OFF); const int n = cur.P0 + 256;
            for (int i = cur.jlo * 64 + tid * 4; i < n; i += 2048) *(LAS v4f*)(kw + i) = *(const v4f*)(kbg + i);
            __syncthreads(); }
        if (first) { att::fox_prime(cur, (char*)lds_g, S, wave_s); first = false; }
        att::BlockRef nxt; bool last;
        att::fox_block(cur, nxt, last, cx, (char*)lds_g, kbl, S, wave_s);
        if (last) break;
        cur = nxt;
    }
}

#ifndef DOUBLE_STEP
#define DOUBLE_STEP -1
#endif
__global__ void __launch_bounds__(512, 2) fox_gmlp_fwd(Params p_unused) {
    extern __shared__ __attribute__((aligned(16))) unsigned char lds_raw[];
    cg::grid_group grid = cg::this_grid();
    LAS unsigned char* lds = (LAS unsigned char*)lds_raw;
    const int G = gridDim.x, bx = blockIdx.x, NGW = G * 8, NGT = G * 512;
    const int wave_s = __builtin_amdgcn_readfirstlane((int)threadIdx.x >> 6);
    volatile LAS unsigned* bst = (volatile LAS unsigned*)(lds + LDS_MISC);
    if (threadIdx.x < 2) bst[threadIdx.x] = 0u;
    grid.sync();
    { PP p0 = (PP)__builtin_amdgcn_kernarg_segment_ptr(); if (threadIdx.x == 0) (void)xb_add((unsigned*)(p0->ws + WS_BAR) + XB_XCNT(xb_xcc_id()), 1u); }
#pragma unroll 1
    for (int it = 0; it < 13 + (DOUBLE_STEP >= 0 ? 1 : 0); ++it) {
        const int step = (DOUBLE_STEP >= 0 && it > DOUBLE_STEP) ? it - 1 : it;
        const int tid = fresh_tid(wave_s);
        const int lane = tid & 63, wave = wave_s, gw = bx * 8 + wave, gtid = bx * 512 + tid;
        PP p = (PP)__builtin_amdgcn_kernarg_segment_ptr(); asm volatile("" : "+s"(p));
        unsigned char* ws = p->ws;
        bf16u* R0 = (bf16u*)(ws + WS_R0); bf16u* S0 = (bf16u*)(ws + WS_S0); bf16u* S1 = (bf16u*)(ws + WS_S1); bf16u* S2 = (bf16u*)(ws + WS_S2); bf16u* S3 = (bf16u*)(ws + WS_S3); bf16u* S4 = (bf16u*)(ws + WS_S4);
        float* rstd0 = (float*)(ws + WS_RSTD0); float* rstd1 = (float*)(ws + WS_RSTD1); float* rstd2 = (float*)(ws + WS_RSTD2);
        float* logf = (float*)(ws + WS_LOGF); float* kbias = (float*)(ws + WS_KBIAS);
        if (step == 0) {
            p0_prologue(p, lds, gw, NGW, lane, wave, gtid, NGT);
        } else if (step == 1 || step == 10) {
            const bool second = step == 10;
            pg8::Gemm g{R0, (const bf16u*)(ws + (second ? WS_WGU2 : WS_WGU1)), T, 2 * FF, DM}; pg8::StaticOrder S; S.init(T, 2 * FF, G, bx);
            pg8::EpiSwiGLU E{S0, second ? rstd2 : rstd0};
            pg8::gemm_phase<pg8::EpiSwiGLU, pg8::StaticOrder, true, true>(lds, g, S, E, wave_s);
        } else if (step == 2 || step == 8 || step == 11) {
            const bf16u* A = step == 8 ? S3 : S0; const bf16u* Bt = (const bf16u*)(ws + (step == 2 ? WS_WD1 : step == 8 ? WS_WOUT : WS_WD2));
            bf16u* Y = step == 8 ? S0 : S4; const int K = step == 8 ? DM : FF;
            pg8::Gemm g{A, Bt, T, DM, K}; pg8::StaticOrder S; S.init(T, DM, G, bx);
            pg8::EpiBf16<0> E{Y, DM, nullptr, 0, 0, 1.f};
            pg8::gemm_phase<pg8::EpiBf16<0>, pg8::StaticOrder, true, true>(lds, g, S, E, wave_s);
        } else if (step == 3 || step == 9 || step == 12) {
            if (step == 3) {
                LAS float* wfl = (LAS float*)lds; const float* Wf = (const float*)(ws + WS_WF);
                for (int i = tid * 4; i < 8 * DM; i += 2048) *(LAS v4f*)(wfl + i) = *(const v4f*)(Wf + i);
                __syncthreads();
                row_pass<1>(p->x, nullptr, S4, p->f1_post_g, 0.5f, nullptr, R0, rstd1, wfl, p->b_forget, logf, gw, NGW, lane);
            } else if (step == 9) {
                row_pass<2>(nullptr, R0, S0, p->mix_post_g, 1.0f, nullptr, R0, rstd2, nullptr, nullptr, nullptr, gw, NGW, lane);
            } else {
                row_pass<2>(nullptr, R0, S4, p->f2_post_g, 0.5f, p->out, nullptr, nullptr, nullptr, nullptr, nullptr, gw, NGW, lane);
            }
        } else if (step == 4 || step == 6) {
            if (step == 4) cumsum_phase(logf, kbias, lds, bx, tid, lane, wave);
            const bool a = step == 4;
            pg8::Gemm g{R0, (const bf16u*)(ws + WS_WIN) + (a ? (size_t)4096 * DM : 0), T, a ? 3072 : 4096, DM}; pg8::StaticOrder S; S.init(T, a ? 3072 : 4096, G, bx);
            pg8::EpiMix E{a ? S0 : S1, (size_t)32 * MiB, a ? 0 : 1, rstd1, (unsigned*)(ws + WS_BAR) + att::CW_NRM};
            pg8::gemm_phase<pg8::EpiMix, pg8::StaticOrder, true, true>(lds, g, S, E, wave_s);
        } else if (step == 5) {
            sgu_phase(p, lds, S0, S1, S2, (const bf16u*)(ws + WS_WSM), G, bx, tid, lane, wave);
        } else if (step == 7) {
            attn_phase(lds_raw, lds, S3, S1, S2, S4, S0, kbias, (unsigned*)(ws + WS_BAR), wave_s);
        }
        if (it != 12 + (DOUBLE_STEP >= 0 ? 1 : 0)) xcd_barrier((unsigned*)(ws + WS_BAR), bst, wave_s == 0 && lane == 0);
    }
}

extern "C" void kernel_launch(void* const* d_in, const int* in_sizes, int n_in, void* d_out, int out_size, void* d_ws, size_t ws_size, hipStream_t stream) {
    static int grid = 0;
    if (grid == 0) {
        if (n_in != 20 || in_sizes[0] != T * DM || out_size != T * DM || ws_size < WS_END) {
            fprintf(stderr, "kernel_launch: unexpected shapes (n_in %d, in0 %d, out %d, ws %zu); nothing launched\n", n_in, n_in > 0 ? in_sizes[0] : -1, out_size, ws_size); grid = -1; return; }
        int dev = 0, cus = 0, per_cu = 0;
        (void)hipGetDevice(&dev); (void)hipDeviceGetAttribute(&cus, hipDeviceAttributeMultiprocessorCount, dev);
        if (hipFuncSetAttribute((const void*)fox_gmlp_fwd, hipFuncAttributeMaxDynamicSharedMemorySize, LDS_TOTAL) != hipSuccess) { fprintf(stderr, "kernel_launch: hipFuncSetAttribute failed\n"); grid = -1; return; }
        if (hipOccupancyMaxActiveBlocksPerMultiprocessor(&per_cu, (const void*)fox_gmlp_fwd, 512, LDS_TOTAL) != hipSuccess || per_cu < 1) { fprintf(stderr, "kernel_launch: occupancy query says %d\n", per_cu); per_cu = 1; }
        (void)hipGetLastError();
        if (per_cu > 1) per_cu = 1;
        grid = cus * per_cu;
    }
    if (grid < 0) return;
    Params p{};
    p.x = (const float*)d_in[0]; p.f1_pre_g = (const float*)d_in[1]; p.f1_wg = (const float*)d_in[2]; p.f1_wu = (const float*)d_in[3]; p.f1_wd = (const float*)d_in[4]; p.f1_post_g = (const float*)d_in[5];
    p.mix_pre_g = (const float*)d_in[6]; p.w_in = (const float*)d_in[7]; p.b_forget = (const float*)d_in[8]; p.ln_g = (const float*)d_in[9]; p.ln_b = (const float*)d_in[10]; p.w_s = (const float*)d_in[11]; p.b_s = (const float*)d_in[12];
    p.w_out = (const float*)d_in[13]; p.mix_post_g = (const float*)d_in[14]; p.f2_pre_g = (const float*)d_in[15]; p.f2_wg = (const float*)d_in[16]; p.f2_wu = (const float*)d_in[17]; p.f2_wd = (const float*)d_in[18]; p.f2_post_g = (const float*)d_in[19];
    p.out = (float*)d_out; p.ws = (unsigned char*)d_ws;
    if (hipMemsetAsync((char*)d_ws + WS_BAR, 0, BAR_BYTES, stream) != hipSuccess) { fprintf(stderr, "kernel_launch: hipMemsetAsync failed\n"); return; }
    void* args[] = {&p};
    hipError_t e = hipLaunchCooperativeKernel((const void*)fox_gmlp_fwd, dim3(grid), dim3(512), args, LDS_TOTAL, stream);
    if (e != hipSuccess) fprintf(stderr, "kernel_launch: cooperative launch failed: %s (grid %d)\n", hipGetErrorString(e), grid);
}
```

```cpp
#include <hip/hip_runtime.h>
#include <hip/hip_cooperative_groups.h>
#include <hip/hip_bf16.h>
#include <cstdio>
#include <cstdint>
namespace cg = cooperative_groups;
namespace pg8 {
#define PG8_LAS __attribute__((address_space(3)))
typedef unsigned short bf16_t;
typedef short bf16x8 __attribute__((ext_vector_type(8)));
typedef float f32x4 __attribute__((ext_vector_type(4)));
typedef unsigned u32x4 __attribute__((ext_vector_type(4)));
constexpr int BM = 256, BK = 64, HALF = 128, HTB = HALF * BK * 2  , STAGE_BYTES = 8 * HTB, NXCD = 8, WGM = 8;

__host__ __device__ __forceinline__ int lds_byte(int r, int c) { const int st = (r >> 4) * 2 + (c >> 5), rr = r & 15, cc = c & 31, ob = rr * 64 + cc * 2; return st * 1024 + (ob ^ (((ob >> 9) & 1) << 5)); }
__host__ __device__ __forceinline__ void stage_rc(int b, int& R, int& C) { const int st = b / 1024, sb = b % 1024, swz = sb ^ (((sb >> 9) & 1) << 5); R = (st >> 1) * 16 + swz / 64; C = (st & 1) * 32 + (swz % 64) / 2; }
__host__ __device__ __forceinline__ int perm32(int rho) { const int n = rho >> 4, i = rho & 15; return 8 * (i >> 2) + 4 * n + (i & 3); }

struct Unit { int pm, pn; };
struct Gemm { const bf16_t* A; const bf16_t* Bt; int M, N, K; };

struct StaticOrder {
    int nM, nN, nwg, G, c;
    __host__ __device__ void init(int M, int N, int G_, int c_) { nM = M / BM; nN = N / BM; nwg = nM * nN; G = G_; c = c_; }
    __host__ __device__ bool next(int i, Unit& u) const {
        const long L = (long)i * G + c; if (L >= nwg) return false;
        int wgid = (int)L; { const int q = nwg / NXCD, r = nwg % NXCD, xcd = wgid % NXCD, off = wgid / NXCD; wgid = (xcd < r ? xcd * (q + 1) : r * (q + 1) + (xcd - r) * q) + off; }
        const int nig = WGM * nN, gid = wgid / nig, fm = gid * WGM, gsz = (nM - fm) < WGM ? (nM - fm) : WGM;
        u.pm = fm + ((wgid % nig) % gsz); u.pn = (wgid % nig) / gsz; return true;
    }
    __device__ __forceinline__ void a_ready(const Unit&) const {}
    __device__ __forceinline__ void done(const Unit&) const {}
};

typedef float cvt_f32x2 __attribute__((ext_vector_type(2))); typedef __bf16 cvt_bf16x2 __attribute__((ext_vector_type(2)));
__device__ __forceinline__ unsigned cvt_pk_bf16(float lo, float hi) { cvt_f32x2 v = {lo, hi}; cvt_bf16x2 b = __builtin_convertvector(v, cvt_bf16x2); return __builtin_bit_cast(unsigned, b); }
typedef float f32x2 __attribute__((ext_vector_type(2)));
__device__ __forceinline__ f32x2 gelu_pk(f32x2 v) {
    const f32x2 av = __builtin_elementwise_abs(v), d = av * 0.2316418882f + 1.0f;
    f32x2 t; t.x = __builtin_amdgcn_rcpf(d.x); t.y = __builtin_amdgcn_rcpf(d.y);
    f32x2 q = t * 0.5307027145f + (-0.7265760135f); q = q * t + 0.7107068705f; q = q * t + (-0.142248368f); q = q * t + 0.127414796f; q = q * t;
    const f32x2 s = (v * v) * (-0.72134752044f);
    f32x2 e; e.x = __builtin_amdgcn_exp2f(s.x); e.y = __builtin_amdgcn_exp2f(s.y);
    const f32x2 m = v * (q * e), r = v - m;
    f32x2 o; o.x = v.x < 0.f ? m.x : r.x; o.y = v.y < 0.f ? m.y : r.y; return o;
}

template <int ACT  > struct EpiBf16 {
    static constexpr bool PERM = true, AFTER_DRAIN = false, RSTD_LDS = false; static_assert(ACT == 0 || ACT == 1, "EpiBf16: ACT is 0 (none) or 1 (gelu_pk)");
    bf16_t* O; int ldc; const float* bias; int split_cols; size_t split_stride; float scale0;
    __device__ __forceinline__ void operator()(const f32x4 (&acc)[2][2][4][2], const Unit& u, int wr, int wc, int fr, int fq) const {
        const int row0 = u.pm * BM + wr * 64 + fr; int colt = u.pn * BM; bf16_t* base = O;
        float sc = 1.f; if (split_cols) { const int t = colt / split_cols; base += (size_t)t * split_stride; colt -= t * split_cols; if (t == 0) sc = scale0; }
        const int col0 = colt + wc * 32 + 8 * fq, bcol0 = u.pn * BM + wc * 32 + 8 * fq;
        f32x4 bv[2][2];
#pragma unroll
        for (int bj = 0; bj < 2; ++bj)
#pragma unroll
            for (int n = 0; n < 2; ++n) bv[bj][n] = bias ? *(const f32x4*)(bias + bcol0 + bj * HALF + 4 * n) : (f32x4){0.f, 0.f, 0.f, 0.f};
#pragma unroll
        for (int ai = 0; ai < 2; ++ai)
#pragma unroll
            for (int m = 0; m < 4; ++m) { bf16_t* rowp = base + (size_t)(row0 + ai * HALF + m * 16) * ldc + col0;
#pragma unroll
                for (int bj = 0; bj < 2; ++bj) { f32x4 v0 = acc[ai][bj][m][0] + bv[bj][0], v1 = acc[ai][bj][m][1] + bv[bj][1];
                    if (ACT == 1) { f32x2 a = gelu_pk((f32x2){v0[0], v0[1]}), b = gelu_pk((f32x2){v0[2], v0[3]}), c = gelu_pk((f32x2){v1[0], v1[1]}), d = gelu_pk((f32x2){v1[2], v1[3]});
                        v0 = (f32x4){a.x, a.y, b.x, b.y}; v1 = (f32x4){c.x, c.y, d.x, d.y}; }
                    v0 = v0 * sc; v1 = v1 * sc; u32x4 w; w.x = cvt_pk_bf16(v0[0], v0[1]); w.y = cvt_pk_bf16(v0[2], v0[3]); w.z = cvt_pk_bf16(v1[0], v1[1]); w.w = cvt_pk_bf16(v1[2], v1[3]);
                    *(u32x4*)(rowp + bj * HALF) = w; } }
    }
};

__device__ __forceinline__ float sigmoid_f(float x) { return __builtin_amdgcn_rcpf(1.0f + __builtin_amdgcn_exp2f(-1.4426950408889634f * x)); }
struct EpiSwiGLU {
    static constexpr bool PERM = true, AFTER_DRAIN = false, RSTD_LDS = true;
    bf16_t* O; const float* rstd;
    __device__ __forceinline__ void operator()(const f32x4 (&acc)[2][2][4][2], const Unit& u, int wr, int wc, int fr, int fq, const PG8_LAS float* rl) const {
        const int row0 = u.pm * BM + wr * 64 + fr, col0 = u.pn * HALF + wc * 32 + 8 * fq; rl += wr * 64 + fr;
#pragma unroll
        for (int ai = 0; ai < 2; ++ai)
#pragma unroll
            for (int m = 0; m < 4; ++m) { const int row = row0 + ai * HALF + m * 16; const float rs = rl[ai * HALF + m * 16];
                u32x4 w; unsigned wv[4];
#pragma unroll
                for (int n = 0; n < 2; ++n) { const f32x4 g = acc[ai][0][m][n] * rs, up = acc[ai][1][m][n] * rs; float o[4];
#pragma unroll
                    for (int j = 0; j < 4; ++j) o[j] = g[j] * sigmoid_f(g[j]) * up[j];
                    wv[2 * n] = cvt_pk_bf16(o[0], o[1]); wv[2 * n + 1] = cvt_pk_bf16(o[2], o[3]); }
                w.x = wv[0]; w.y = wv[1]; w.z = wv[2]; w.w = wv[3];
                __builtin_nontemporal_store(w, (u32x4*)(O + (size_t)row * 4096 + col0)); }
    }
};
struct EpiMix {
    static constexpr bool PERM = true, AFTER_DRAIN = false, RSTD_LDS = true;
    bf16_t* O; size_t stride; int mode; const float* rstd;
    unsigned* nrm;
    template <int ACT> __device__ __forceinline__ void body(const f32x4 (&acc)[2][2][4][2], bf16_t* base, int row0, int col0, const PG8_LAS float* rl) const {
#pragma unroll
        for (int ai = 0; ai < 2; ++ai)
#pragma unroll
            for (int m = 0; m < 4; ++m) { const int row = row0 + ai * HALF + m * 16; const float rs = rl[ai * HALF + m * 16]; bf16_t* rowp = base + (size_t)row * 1024 + col0;
#pragma unroll
                for (int bj = 0; bj < 2; ++bj) { f32x4 v0 = acc[ai][bj][m][0] * rs, v1 = acc[ai][bj][m][1] * rs;
                    if (ACT == 1) { f32x2 a = gelu_pk((f32x2){v0[0], v0[1]}), b = gelu_pk((f32x2){v0[2], v0[3]}), c = gelu_pk((f32x2){v1[0], v1[1]}), d = gelu_pk((f32x2){v1[2], v1[3]});
                        v0 = (f32x4){a.x, a.y, b.x, b.y}; v1 = (f32x4){c.x, c.y, d.x, d.y}; }
                    if (ACT == 2) {
#pragma unroll
                        for (int j = 0; j < 4; ++j) { v0[j] = sigmoid_f(v0[j]); v1[j] = sigmoid_f(v1[j]); } }
                    u32x4 w; w.x = cvt_pk_bf16(v0[0], v0[1]); w.y = cvt_pk_bf16(v0[2], v0[3]); w.z = cvt_pk_bf16(v1[0], v1[1]); w.w = cvt_pk_bf16(v1[2], v1[3]);
                    *(u32x4*)(rowp + bj * HALF) = w; } }
    }
    __device__ __forceinline__ void operator()(const f32x4 (&acc)[2][2][4][2], const Unit& u, int wr, int wc, int fr, int fq, const PG8_LAS float* rl) const {
        rl += wr * 64 + fr;
        const int t = (u.pn * BM) >> 10, colt = u.pn * BM - (t << 10);
        bf16_t* base = O + (size_t)t * stride; const int a = mode == 0 ? (t < 2 ? 1 : 2) : (t == 3 ? 2 : 0);
        const int row0 = u.pm * BM + wr * 64 + fr, col0 = colt + wc * 32 + 8 * fq;
        if (a == 0) body<0>(acc, base, row0, col0, rl); else if (a == 1) body<1>(acc, base, row0, col0, rl); else body<2>(acc, base, row0, col0, rl);
        if (mode == 1 && (t == 0 || t == 2)) {
            float mx[2] = {0.f, 0.f};
#pragma unroll
            for (int ai = 0; ai < 2; ++ai)
#pragma unroll
                for (int m = 0; m < 4; ++m) { const float rs = rl[ai * HALF + m * 16];
#pragma unroll
                    for (int bj = 0; bj < 2; ++bj) { const f32x4 v0 = acc[ai][bj][m][0] * rs, v1 = acc[ai][bj][m][1] * rs;
                        float s = (v0[0] * v0[0] + v0[1] * v0[1]) + (v0[2] * v0[2] + v0[3] * v0[3]) + (v1[0] * v1[0] + v1[1] * v1[1]) + (v1[2] * v1[2] + v1[3] * v1[3]);
                        s += __int_as_float(__builtin_amdgcn_ds_swizzle(__float_as_int(s), (16 << 10) | 0x1f));
                        { auto rr = __builtin_amdgcn_permlane32_swap(__float_as_uint(s), __float_as_uint(s), false, false); s = __uint_as_float(rr[0]) + __uint_as_float(rr[1]); }
                        mx[bj] = fmaxf(mx[bj], s); } }
#pragma unroll
            for (int bj = 0; bj < 2; ++bj) { float v = mx[bj];
                v = fmaxf(v, __int_as_float(__builtin_amdgcn_ds_swizzle(__float_as_int(v), (1 << 10) | 0x1f))); v = fmaxf(v, __int_as_float(__builtin_amdgcn_ds_swizzle(__float_as_int(v), (2 << 10) | 0x1f)));
                v = fmaxf(v, __int_as_float(__builtin_amdgcn_ds_swizzle(__float_as_int(v), (4 << 10) | 0x1f))); v = fmaxf(v, __int_as_float(__builtin_amdgcn_ds_swizzle(__float_as_int(v), (8 << 10) | 0x1f)));
                mx[bj] = v; }
            if (fr == 0 && fq == 0) { const int b = u.pm >> 5;
#pragma unroll
                for (int bj = 0; bj < 2; ++bj) { const int bh = b * 8 + (u.pn & 3) * 2 + bj; atomicMax(nrm + ((bh * 2 + (t == 0 ? 1 : 0)) * 4 + wc), __float_as_uint(mx[bj])); } }
        }
    }
};
template <class Epi, class Sched, bool ALIGN_EPI = false, bool SP2 = false>
__device__ __forceinline__ void gemm_phase(PG8_LAS unsigned char* lds, const Gemm g, const Sched& S, const Epi& E, int wave_s) {
    int tid = 0; asm volatile("" : "+v"(tid)); tid = wave_s * 64 + (int)__builtin_amdgcn_mbcnt_hi(~0u, __builtin_amdgcn_mbcnt_lo(~0u, (unsigned)tid)); asm volatile("" : "+v"(tid));
    const int wid = __builtin_amdgcn_readfirstlane(tid >> 6), lane = tid & 63, wr = wid >> 2, wc = wid & 3, fr = lane & 15, fq = lane >> 4;
    const int K = g.K, nt = K / BK;
    unsigned voffA[2], voffB[2];
#pragma unroll
    for (int i = 0; i < 2; ++i) { int R, C; stage_rc(tid * 16 + i * 8192, R, C); const int Rb = Epi::PERM ? ((R & ~31) + perm32(R & 31)) : R;
        voffA[i] = (unsigned)(R * K + C) * 2u; voffB[i] = (unsigned)(Rb * K + C) * 2u; }
    const size_t kstep = (size_t)(BK * 2);
    const size_t hstep = (size_t)HALF * K * 2;
    const size_t tstep = 2 * hstep;
    const unsigned ldsw = (unsigned)wid * 1024u;
    const int aoff = lds_byte(wr * 64 + fr, fq * 8), boff = lds_byte(wc * 32 + fr, fq * 8);
#define PG8_SA(b, h) (((b) * 2 + (h)) * HTB)
#define PG8_SB(b, h) ((4 + (b) * 2 + (h)) * HTB)
#define PG8_STAGE(bufoff, gbase, voff) do { _Pragma("unroll") for (int _i = 0; _i < 2; ++_i) \
        __builtin_amdgcn_global_load_lds((const unsigned*)((const char*)(gbase) + (voff)[_i]), (PG8_LAS unsigned*)(lds + (bufoff) + ldsw + _i * 8192), 16, 0, 0); } while (0)
#define PG8_LDA(dst, b, h) do { _Pragma("unroll") for (int m = 0; m < 4; ++m) _Pragma("unroll") for (int k = 0; k < 2; ++k) dst[m][k] = *(const PG8_LAS bf16x8*)(lds + PG8_SA(b, h) + aoff + m * 2048 + k * 1024); } while (0)
#define PG8_LDB(dst, b, h) do { _Pragma("unroll") for (int n = 0; n < 2; ++n) _Pragma("unroll") for (int k = 0; k < 2; ++k) dst[n][k] = *(const PG8_LAS bf16x8*)(lds + PG8_SB(b, h) + boff + n * 2048 + k * 1024); } while (0)
#define PG8_MMA(ai, bj, At, Bt) do { __builtin_amdgcn_s_setprio(1); _Pragma("unroll") for (int m = 0; m < 4; ++m) _Pragma("unroll") for (int n = 0; n < 2; ++n) _Pragma("unroll") for (int k = 0; k < 2; ++k) \
        acc[ai][bj][m][n] = __builtin_amdgcn_mfma_f32_16x16x32_bf16(Bt[n][k], At[m][k], acc[ai][bj][m][n], 0, 0, 0); __builtin_amdgcn_s_setprio(0); } while (0)
#define PG8_WAIT_V(n) asm volatile("s_waitcnt vmcnt(" #n ")" ::: "memory")
#define PG8_WAIT_L(n) asm volatile("s_waitcnt lgkmcnt(" #n ")" ::: "memory")
#define PG8_BAR __builtin_amdgcn_s_barrier()
#define PG8_SCHED __builtin_amdgcn_sched_barrier(0)
    Unit cur, nxt; int ui = 0;
    if (!S.next(0, cur)) return;
    f32x4 acc[2][2][4][2];
#pragma unroll
    for (int a = 0; a < 2; ++a)
#pragma unroll
        for (int b = 0; b < 2; ++b)
#pragma unroll
            for (int m = 0; m < 4; ++m)
#pragma unroll
                for (int n = 0; n < 2; ++n) acc[a][b][m][n] = (f32x4){0.f, 0.f, 0.f, 0.f};
    bf16x8 At[4][2], B0[2][2], B1[2][2];
    const char* cA = (const char*)g.A + (size_t)cur.pm * tstep; const char* cB = (const char*)g.Bt + (size_t)cur.pn * tstep;
    S.a_ready(cur);
    if constexpr (Epi::RSTD_LDS) { if (wid < 4) __builtin_amdgcn_global_load_lds((const unsigned*)(E.rstd + cur.pm * BM + wid * 64 + lane), (PG8_LAS unsigned*)(lds + STAGE_BYTES + wid * 256), 4, 0, 0); }
    if constexpr (SP2) {
        PG8_STAGE(PG8_SB(0, 0), cB, voffB); PG8_STAGE(PG8_SB(0, 1), cB + hstep, voffB); PG8_STAGE(PG8_SA(0, 0), cA, voffA); PG8_STAGE(PG8_SA(0, 1), cA + hstep, voffA);
        if (wr == 1) PG8_BAR;
        PG8_WAIT_V(2); PG8_BAR;
        PG8_STAGE(PG8_SB(1, 0), cB + kstep, voffB); PG8_STAGE(PG8_SA(1, 0), cA + kstep, voffA); PG8_STAGE(PG8_SB(1, 1), cB + hstep + kstep, voffB);
        PG8_WAIT_V(6); PG8_BAR;
    } else {
        PG8_STAGE(PG8_SB(0, 0), cB, voffB); PG8_STAGE(PG8_SA(0, 0), cA, voffA); PG8_STAGE(PG8_SB(0, 1), cB + hstep, voffB); PG8_STAGE(PG8_SA(0, 1), cA + hstep, voffA);
        if (wr == 1) PG8_BAR;
        PG8_WAIT_V(4); PG8_BAR;
        PG8_STAGE(PG8_SB(1, 0), cB + kstep, voffB); PG8_STAGE(PG8_SA(1, 0), cA + kstep, voffA); PG8_STAGE(PG8_SB(1, 1), cB + hstep + kstep, voffB);
        PG8_WAIT_V(6); PG8_BAR;
    }
    for (;;) {
        const bool has_next = S.next(ui + 1, nxt);
        const char* nA = has_next ? (const char*)g.A + (size_t)nxt.pm * tstep : cA; const char* nB = has_next ? (const char*)g.Bt + (size_t)nxt.pn * tstep : cB;
        for (int t = 0; t < nt; t += 2) {
            const bool last = (t == nt - 2);
            const char* a1 = cA + (size_t)(t + 1) * kstep;
            const char* a2 = last ? nA : cA + (size_t)(t + 2) * kstep; const char* b2 = last ? nB : cB + (size_t)(t + 2) * kstep;
            const char* a3 = a2 + kstep; const char* b3 = b2 + kstep;
            if (last && has_next) S.a_ready(nxt);
            if constexpr (Epi::RSTD_LDS) { if (last && has_next && wid < 4) __builtin_amdgcn_global_load_lds((const unsigned*)(E.rstd + nxt.pm * BM + wid * 64 + lane), (PG8_LAS unsigned*)(lds + STAGE_BYTES + ((ui + 1) & 1) * 1024 + wid * 256), 4, 0, 0); }
            if constexpr (SP2) {
            PG8_LDB(B0, 0, 0); PG8_LDB(B1, 0, 1); PG8_SCHED; PG8_LDA(At, 0, 0); PG8_STAGE(PG8_SA(1, 1), a1 + hstep, voffA);
            PG8_WAIT_V(8); PG8_WAIT_L(0); PG8_BAR; PG8_MMA(0, 0, At, B0); PG8_MMA(0, 1, At, B1); PG8_BAR; PG8_SCHED;
            PG8_LDA(At, 0, 1); PG8_STAGE(PG8_SB(0, 0), b2, voffB); PG8_STAGE(PG8_SB(0, 1), b2 + hstep, voffB); PG8_STAGE(PG8_SA(0, 0), a2, voffA);
            PG8_WAIT_V(8); PG8_WAIT_L(0); PG8_BAR; PG8_MMA(1, 0, At, B0); PG8_MMA(1, 1, At, B1); PG8_BAR; PG8_SCHED;
            PG8_LDB(B0, 1, 0); PG8_LDB(B1, 1, 1); PG8_SCHED; PG8_LDA(At, 1, 0); PG8_STAGE(PG8_SA(0, 1), a2 + hstep, voffA);
            PG8_WAIT_V(8); PG8_WAIT_L(0); PG8_BAR; PG8_MMA(0, 0, At, B0); PG8_MMA(0, 1, At, B1); PG8_BAR; PG8_SCHED;
            PG8_LDA(At, 1, 1); PG8_STAGE(PG8_SB(1, 0), b3, voffB); PG8_STAGE(PG8_SB(1, 1), b3 + hstep, voffB); PG8_STAGE(PG8_SA(1, 0), a3, voffA);
            PG8_WAIT_V(8); PG8_WAIT_L(0); PG8_BAR; PG8_MMA(1, 0, At, B0); PG8_MMA(1, 1, At, B1); PG8_BAR; PG8_SCHED;
            } else {
            PG8_LDB(B0, 0, 0); PG8_SCHED; PG8_LDA(At, 0, 0); PG8_STAGE(PG8_SA(1, 1), a1 + hstep, voffA);
            PG8_WAIT_L(8); PG8_BAR; PG8_WAIT_L(0); PG8_MMA(0, 0, At, B0); PG8_BAR; PG8_SCHED;
            PG8_LDB(B1, 0, 1); PG8_STAGE(PG8_SB(0, 0), b2, voffB);
            PG8_BAR; PG8_WAIT_L(0); PG8_MMA(0, 1, At, B1); PG8_BAR;
            PG8_LDA(At, 0, 1); PG8_STAGE(PG8_SA(0, 0), a2, voffA);
            PG8_BAR; PG8_WAIT_L(0); PG8_MMA(1, 0, At, B0); PG8_BAR; PG8_SCHED;
            PG8_STAGE(PG8_SB(0, 1), b2 + hstep, voffB);
            PG8_WAIT_V(6); PG8_BAR; PG8_MMA(1, 1, At, B1); PG8_BAR;
            PG8_LDB(B0, 1, 0); PG8_SCHED; PG8_LDA(At, 1, 0); PG8_STAGE(PG8_SA(0, 1), a2 + hstep, voffA);
            PG8_WAIT_L(8); PG8_BAR; PG8_WAIT_L(0); PG8_MMA(0, 0, At, B0); PG8_BAR; PG8_SCHED;
            PG8_LDB(B1, 1, 1); PG8_STAGE(PG8_SB(1, 0), b3, voffB);
            PG8_BAR; PG8_WAIT_L(0); PG8_MMA(0, 1, At, B1); PG8_BAR;
            PG8_LDA(At, 1, 1); PG8_STAGE(PG8_SA(1, 0), a3, voffA);
            PG8_BAR; PG8_WAIT_L(0); PG8_MMA(1, 0, At, B0); PG8_BAR; PG8_SCHED;
            PG8_STAGE(PG8_SB(1, 1), b3 + hstep, voffB);
            PG8_WAIT_V(6); PG8_BAR; PG8_MMA(1, 1, At, B1); PG8_BAR;
            }
        }
        if constexpr (ALIGN_EPI) { if (wr == 0) PG8_BAR; }
        if constexpr (!Epi::AFTER_DRAIN) { if constexpr (Epi::RSTD_LDS) E(acc, cur, wr, wc, fr, fq, (const PG8_LAS float*)(lds + STAGE_BYTES + (ui & 1) * 1024)); else E(acc, cur, wr, wc, fr, fq); S.done(cur); }
        if (!has_next) break;
#pragma unroll
        for (int a = 0; a < 2; ++a)
#pragma unroll
            for (int b = 0; b < 2; ++b)
#pragma unroll
                for (int m = 0; m < 4; ++m)
#pragma unroll
                    for (int n = 0; n < 2; ++n) acc[a][b][m][n] = (f32x4){0.f, 0.f, 0.f, 0.f};
        cur = nxt; cA = nA; cB = nB; ++ui;
        if constexpr (ALIGN_EPI) { if (wr == 1) PG8_BAR; }
    }
    PG8_WAIT_V(0);
    if constexpr (!ALIGN_EPI) { if (wr == 0) PG8_BAR; }
    PG8_BAR;
    if constexpr (Epi::AFTER_DRAIN) { E.fused(acc, cur, wr, wc, fr, fq, lds, wid, lane); S.done(cur); }
#undef PG8_SA
#undef PG8_SB
#undef PG8_STAGE
#undef PG8_LDA
#undef PG8_LDB
#undef PG8_MMA
#undef PG8_WAIT_V
#undef PG8_WAIT_L
#undef PG8_BAR
#undef PG8_SCHED
}
}

namespace att {
#define ALAS __attribute__((address_space(3)))
constexpr int D = 128, RS = 1024;
constexpr float SCALE = 0.08838834764831845f;
constexpr float THR = 8.f;
constexpr bool WSKIP = false;
constexpr int NW = 8, QBLK = 32, KVBLK = 64, QB = NW * QBLK;
constexpr int SHM_V = KVBLK * D * 2, SHM_K = KVBLK * D * 2;
constexpr int LDS_CORE = 2 * SHM_V + 2 * SHM_K + NW * 64 * 4;
constexpr int KB_OFF = LDS_CORE;
constexpr int LDS_BYTES = KB_OFF + 8192 * 4;
using bf16 = __hip_bfloat16;
typedef short bf16x8 __attribute__((ext_vector_type(8)));
typedef short s16x4 __attribute__((ext_vector_type(4)));
typedef float f32x16 __attribute__((ext_vector_type(16)));
typedef float f32x4 __attribute__((ext_vector_type(4)));
typedef unsigned u32x4 __attribute__((ext_vector_type(4)));
template <class A, class Bt> struct same_t { static constexpr bool v = false; };
template <class A> struct same_t<A, A> { static constexpr bool v = true; };

#define KSWZ(row, colB) ((row) * 256 + ((colB) ^ (((row) & 7) << 4)))
#define SBAR() __builtin_amdgcn_sched_barrier(0)
__device__ __forceinline__ int v_st(int k, int c) { const int kk = (k & ~0xC) | ((k & 4) << 1) | ((k & 8) >> 1); return ((kk >> 3) * 4 + (c >> 5)) * 512 + ((kk & 7) * 32 + (c & 31)) * 2; }
__device__ __forceinline__ int v_rd_base(int lane) { return ((lane & 3) << 3) | (((lane >> 2) & 3) << 6) | (((lane >> 4) & 1) << 5) | (((lane >> 5) & 1) << 8); }
constexpr int v_rd_off(int d0, int ks, int half) { return d0 * 512 + ks * 4096 + half * 2048; }
__device__ __forceinline__ int crow(int r, int hi) { return (r & 3) + 8 * (r >> 2) + 4 * hi; }
__device__ __forceinline__ unsigned cvtpk(float lo, float hi) {
    typedef float f32x2_t __attribute__((ext_vector_type(2))); typedef __bf16 bf16x2_t __attribute__((ext_vector_type(2)));
    f32x2_t v = {lo, hi}; bf16x2_t b = __builtin_convertvector(v, bf16x2_t); return __builtin_bit_cast(unsigned, b);
}
__device__ __forceinline__ bf16x8 pack8(f32x4 a, f32x4 b) {
    u32x4 w = {cvtpk(a[0], a[1]), cvtpk(a[2], a[3]), cvtpk(b[0], b[1]), cvtpk(b[2], b[3])};
    return *reinterpret_cast<bf16x8*>(&w);
}
template <class T> __device__ __forceinline__ bf16x8 load8(const T* p) {
    if constexpr (same_t<T, float>::v) { return pack8(*(const f32x4*)p, *(const f32x4*)(p + 4)); }
    else { return *reinterpret_cast<const bf16x8*>(p); }
}
__device__ __forceinline__ void mask_tile(f32x16& p0, f32x16& p1, int dq, unsigned W) {
    const float NEG = -__builtin_inff();
#pragma unroll
    for (int r = 0; r < 16; ++r) {
        const int c = (r & 3) + 8 * (r >> 2);
        if ((unsigned)(dq - c) >= W) p0[r] = NEG;
        if ((unsigned)(dq - c - 32) >= W) p1[r] = NEG;
    }
}
__device__ __forceinline__ void partialSM(f32x16& p0, f32x16& p1, float& m_reg, float& mn, float& alpha) {
    float pmax = p0[0]; for (int r = 1; r < 16; ++r) pmax = fmaxf(pmax, p0[r]); for (int r = 0; r < 16; ++r) pmax = fmaxf(pmax, p1[r]);
    { auto rr = __builtin_amdgcn_permlane32_swap(__float_as_uint(pmax), __float_as_uint(pmax), false, false);
      pmax = fmaxf(__uint_as_float(rr[0]), __uint_as_float(rr[1])); }
    constexpr float C2 = 1.4426950408889634f * SCALE;
    if (__builtin_expect(__all((pmax - m_reg) * SCALE <= THR), 1)) { mn = m_reg; alpha = 1.f; }
    else { mn = fmaxf(m_reg, pmax); alpha = __builtin_amdgcn_exp2f((m_reg - mn) * C2); m_reg = mn; }
    const float mnL = -mn * C2;
    for (int r = 0; r < 16; ++r) p0[r] = fmaf(p0[r], C2, mnL); for (int r = 0; r < 16; ++r) p1[r] = fmaf(p1[r], C2, mnL);
    for (int r = 0; r < 16; ++r) p0[r] = __builtin_amdgcn_exp2f(p0[r]);
}
__device__ __forceinline__ void finishSM(f32x16& p0, f32x16& p1, float alpha, float& l_reg, bf16x8& pa0, bf16x8& pa1, bf16x8& pa2, bf16x8& pa3) {
    for (int r = 0; r < 16; ++r) p1[r] = __builtin_amdgcn_exp2f(p1[r]);
    float ps = 0; for (int r = 0; r < 16; ++r) ps += p0[r]; for (int r = 0; r < 16; ++r) ps += p1[r];
    { auto rr = __builtin_amdgcn_permlane32_swap(__float_as_uint(ps), __float_as_uint(ps), false, false);
      ps = __uint_as_float(rr[0]) + __uint_as_float(rr[1]); }
    l_reg = l_reg * alpha + ps;
#define PK4(P, B_, OUT) do { unsigned a0 = cvtpk(P[B_+0], P[B_+1]), a1 = cvtpk(P[B_+2], P[B_+3]);                          \
        unsigned b0 = cvtpk(P[B_+4], P[B_+5]), b1 = cvtpk(P[B_+6], P[B_+7]);                                             \
        auto r0 = __builtin_amdgcn_permlane32_swap(a0, b0, false, false); auto r1 = __builtin_amdgcn_permlane32_swap(a1, b1, false, false); \
        u32x4 w = {r0[0], r1[0], r0[1], r1[1]}; OUT = *reinterpret_cast<bf16x8*>(&w); } while (0)
    PK4(p0, 0, pa0); PK4(p0, 8, pa1); PK4(p1, 0, pa2); PK4(p1, 8, pa3);
#undef PK4
}
template <int KB>
__device__ __forceinline__ void qkt(f32x16& p0, f32x16& p1, const char* K_lds, int r32, int hi, const bf16x8* qr, const ALAS float* kbt) {
#pragma unroll
    for (int g = 0; g < 4; ++g) { const f32x4 a = *(const ALAS f32x4*)(kbt + 8 * g), b = *(const ALAS f32x4*)(kbt + 32 + 8 * g);
        p0[4 * g] = a[0]; p0[4 * g + 1] = a[1]; p0[4 * g + 2] = a[2]; p0[4 * g + 3] = a[3];
        p1[4 * g] = b[0]; p1[4 * g + 1] = b[1]; p1[4 * g + 2] = b[2]; p1[4 * g + 3] = b[3]; }
    const char* kb[4];
#pragma unroll
    for (int dd = 0; dd < 4; ++dd) kb[dd] = K_lds + KB * SHM_K + KSWZ(r32, (dd * 16 + hi * 8) * 2);
#pragma unroll
    for (int d0 = 0; d0 < 8; ++d0) { const char* a = kb[d0 & 3] + (d0 >> 2) * 128;
        bf16x8 b0 = *reinterpret_cast<const bf16x8*>(a);
        bf16x8 b1 = *reinterpret_cast<const bf16x8*>(a + 32 * 256);
        p0 = __builtin_amdgcn_mfma_f32_32x32x16_bf16(b0, qr[d0], p0, 0, 0, 0);
        p1 = __builtin_amdgcn_mfma_f32_32x32x16_bf16(b1, qr[d0], p1, 0, 0, 0); }
}
template <int VB, bool SK>
__device__ __forceinline__ void pv_tile(f32x16* o, int vb0, bf16x8 pa0, bf16x8 pa1, bf16x8 pa2, bf16x8 pa3, bool act) {
    if (SK && !act) return;
#define TRRD(dst, off) asm volatile("ds_read_b64_tr_b16 %0, %1 offset:%2" : "=&v"(dst) : "v"(vb0), "i"(off) : "memory")
#define PV_D0(d0) do { s16x4 l0, l1, l2, l3, h0, h1, h2, h3; constexpr int b_ = VB * SHM_V + v_rd_off(d0, 0, 0);     \
        TRRD(l0, b_); TRRD(h0, b_ + 2048); TRRD(l1, b_ + 4096); TRRD(h1, b_ + 6144); TRRD(l2, b_ + 8192); TRRD(h2, b_ + 10240); TRRD(l3, b_ + 12288); TRRD(h3, b_ + 14336); \
        asm volatile("s_waitcnt lgkmcnt(0)" ::: "memory"); SBAR();                 \
        o[d0] = __builtin_amdgcn_mfma_f32_32x32x16_bf16(pa0, (bf16x8){l0[0], l0[1], l0[2], l0[3], h0[0], h0[1], h0[2], h0[3]}, o[d0], 0, 0, 0);   \
        o[d0] = __builtin_amdgcn_mfma_f32_32x32x16_bf16(pa1, (bf16x8){l1[0], l1[1], l1[2], l1[3], h1[0], h1[1], h1[2], h1[3]}, o[d0], 0, 0, 0);   \
        o[d0] = __builtin_amdgcn_mfma_f32_32x32x16_bf16(pa2, (bf16x8){l2[0], l2[1], l2[2], l2[3], h2[0], h2[1], h2[2], h2[3]}, o[d0], 0, 0, 0);   \
        o[d0] = __builtin_amdgcn_mfma_f32_32x32x16_bf16(pa3, (bf16x8){l3[0], l3[1], l3[2], l3[3], h3[0], h3[1], h3[2], h3[3]}, o[d0], 0, 0, 0); } while (0)
    PV_D0(0); PV_D0(1); PV_D0(2); PV_D0(3);
#undef PV_D0
#undef TRRD
}

struct BlockRef { const bf16* Q; const bf16* K; const bf16* V; bf16* O; const bf16* GA; const bf16* OB; int P0; int jlo; int bh; };
struct Seam { bf16x8 qr[8]; bf16x8 st_v0, st_v1, st_k0, st_k1; };
#define VMW() asm volatile("s_waitcnt vmcnt(0)" ::: "memory")
#define VMWN(n) asm volatile("s_waitcnt vmcnt(%0)" :: "i"(n) : "memory")
#define SLOAD_H(Kp, Vp, k0) do { const bf16* kt_ = (Kp) + (size_t)(k0) * RS; const bf16* vt_ = (Vp) + (size_t)(k0) * RS;                      \
                         S.st_v0 = load8<bf16>(vt_ + kvo0); S.st_v1 = load8<bf16>(vt_ + kvo1);                                       \
                         S.st_k0 = load8<bf16>(kt_ + kvo0); S.st_k1 = load8<bf16>(kt_ + kvo1); } while (0)
#define SWRITE_HK(bf) do { *(bf16x8*)(K_lds + (bf) * SHM_K + kws) = S.st_k0; *(bf16x8*)(K_lds + (bf) * SHM_K + kws + 32 * 256) = S.st_k1; } while (0)
#define SWRITE_HV(bf) do { *(bf16x8*)(V_lds + (bf) * SHM_V + vst0) = S.st_v0; *(bf16x8*)(V_lds + (bf) * SHM_V + vst1) = S.st_v1; } while (0)
#define SWRITE_H(bf) do { SWRITE_HV(bf); SWRITE_HK(bf); } while (0)
__device__ __forceinline__ void fox_prime(const BlockRef& cur, char* lds, Seam& S, int wave_s) {
    int tid = 0; asm volatile("" : "+v"(tid)); tid = wave_s * 64 + (int)__builtin_amdgcn_mbcnt_hi(~0u, __builtin_amdgcn_mbcnt_lo(~0u, (unsigned)tid)); asm volatile("" : "+v"(tid));
    const int wid = __builtin_amdgcn_readfirstlane(tid >> 6), lane = tid & 63, r32 = lane & 31, hi = lane >> 5;
    const int sr = tid >> 4, sc = (tid & 15) * 8, kws = KSWZ(sr, sc * 2); char* K_lds = lds + 2 * SHM_V;
    const unsigned kvo0 = (unsigned)(sr * RS + sc), kvo1 = kvo0 + 32u * RS, qo = (unsigned)(r32 * RS + hi * 8);
    { const bf16* qb_ = cur.Q + (size_t)(wid * QBLK) * RS;
#pragma unroll
    for (int d0 = 0; d0 < 8; ++d0) S.qr[d0] = load8<bf16>(qb_ + qo + d0 * 16); }
    SLOAD_H(cur.K, cur.V, cur.jlo * KVBLK); VMW(); SWRITE_HK(0);
    __syncthreads();
}
constexpr int CW_QCTR = 3584, CW_NRM = 3616;
constexpr float FOX_L = 40.0f;
struct FoxCtx { unsigned short* Qb; const unsigned short* Kb; const unsigned short* Vb; const unsigned short* GAb; const unsigned short* OBb; const float* kbias; unsigned* ctl; volatile ALAS unsigned* slot; };
__device__ __forceinline__ BlockRef fox_mkref(int n, const FoxCtx& cx, int lane) {
    unsigned short* Qb = cx.Qb; const unsigned short* Kb = cx.Kb; const unsigned short* Vb = cx.Vb; const unsigned short* GAb = cx.GAb; const unsigned short* OBb = cx.OBb; const float* kbias = cx.kbias; const unsigned* ctl = cx.ctl;
    const int bh = n & 31, qb = 31 - (n >> 5), b = bh >> 3, h = bh & 7;
    const size_t qo = ((size_t)b * 8192 + (size_t)qb * 256) * RS + h * 128, ko = (size_t)b * 8192 * RS + h * 128;
    BlockRef r; r.Q = (const bf16*)(Qb + qo); r.O = (bf16*)(Qb + qo); r.K = (const bf16*)(Kb + ko); r.V = (const bf16*)(Vb + ko);
    r.GA = (const bf16*)(GAb + qo); r.OB = (const bf16*)(OBb + qo); r.P0 = qb * 256; r.bh = bh;
    const float* kbg = kbias + (size_t)bh * 8192; const int nt0 = r.P0 >> 6;
    const float kb0 = kbg[r.P0], ka = kbg[64 * lane + 63], kb_ = kbg[64 * (lane + 64) + 63];
    f32x4 qv_, kv_;
    { const unsigned* np_ = ctl + CW_NRM + bh * 8;
      asm volatile("global_load_dwordx4 %0, %2, off sc0 sc1\n\tglobal_load_dwordx4 %1, %2, off offset:16 sc0 sc1\n\ts_waitcnt vmcnt(0)" : "=&v"(qv_), "=&v"(kv_) : "v"(np_) : "memory"); }
    const float qn2 = (qv_.x + qv_.y) + (qv_.z + qv_.w), kn2 = (kv_.x + kv_.y) + (kv_.z + kv_.w);
    const float thr = FOX_L * 11.313708498984761f + 2.05f * sqrtf(qn2 * kn2);
    const int cnt = __popcll(__ballot(lane < nt0 && (kb0 - ka) > thr)) + __popcll(__ballot(lane + 64 < nt0 && (kb0 - kb_) > thr));
    r.jlo = __builtin_amdgcn_readfirstlane(cnt);
    return r;
}
__device__ __forceinline__ unsigned fox_fetch(unsigned* ctl) { return __hip_atomic_fetch_add(ctl + CW_QCTR, 1u, __ATOMIC_RELAXED, __HIP_MEMORY_SCOPE_AGENT); }
__device__ __forceinline__ void fox_block(const BlockRef& cur, BlockRef& nxt, bool& last, const FoxCtx& cx, char* lds, const ALAS float* kbl, Seam& S, int wave_s) {
    int tid = 0; asm volatile("" : "+v"(tid)); tid = wave_s * 64 + (int)__builtin_amdgcn_mbcnt_hi(~0u, __builtin_amdgcn_mbcnt_lo(~0u, (unsigned)tid)); asm volatile("" : "+v"(tid));
    const int wid = __builtin_amdgcn_readfirstlane(tid >> 6), lane = tid & 63, r32 = lane & 31, hi = lane >> 5;
    constexpr int W = 1 << 30; constexpr bool SK = false;
    const int j_lo = cur.jlo, NT = (cur.P0 + QB - 1) / KVBLK + 1 - j_lo;
    const int qlo = cur.P0 + wid * QBLK, qm = qlo + r32 - 4 * hi;
    char* V_lds = lds; char* K_lds = lds + 2 * SHM_V;
    float* ws = (float*)(lds + 2 * SHM_V + 2 * SHM_K) + wid * 64; float* li_l = ws, * al_l = ws + 32;
    float m_reg = -1e30f, l_reg = 0; f32x16 o[4] = {};
    const int sr = tid >> 4, sc = (tid & 15) * 8, vst0 = v_st(sr, sc), vst1 = v_st(32 + sr, sc), kws = KSWZ(sr, sc * 2);
    const int vb0 = (int)(uintptr_t)V_lds + v_rd_base(lane);
    const unsigned kvo0 = (unsigned)(sr * RS + sc), kvo1 = kvo0 + 32u * RS, qo = (unsigned)(r32 * RS + hi * 8);
    const bf16* Kh = cur.K; const bf16* Vh = cur.V;
    const ALAS float* kbh = kbl + 4 * hi;
#define RESC(a) do { if (__any((a) < 1.f)) { if (hi == 0) al_l[r32] = (a); asm volatile("s_waitcnt lgkmcnt(0)" ::: "memory");              \
                     for (int d_ = 0; d_ < 4; ++d_) for (int r = 0; r < 16; ++r) o[d_][r] *= al_l[crow(r, hi)]; } } while (0)
#define KBASE(t) ((j_lo + (t)) * KVBLK)
#define MASKT(P0_, P1_, t) do { const int kb_ = KBASE(t); if (kb_ + KVBLK - 1 > qlo) mask_tile(P0_, P1_, qm - kb_, (unsigned)W); } while (0)
    constexpr int NQL = 8;
#define SEAM_K0() do { VMWN(NQL); SWRITE_HK(0); SBAR(); } while (0)
    f32x16 pA0, pA1, pB0, pB1; float mnA, mnB, alA, alB; bf16x8 pa0, pa1, pa2, pa3;
    SWRITE_HV(0); SBAR();
    if (NT > 1) { SLOAD_H(Kh, Vh, KBASE(1)); }
    SBAR(); qkt<0>(pA0, pA1, K_lds, r32, hi, S.qr, kbh + KBASE(0));
    MASKT(pA0, pA1, 0); partialSM(pA0, pA1, m_reg, mnA, alA);
    if (NT > 1) { VMW(); SWRITE_H(1); }
    __syncthreads();
#define HALF_STEP(PX0, PX1, mnX, alX, PY0, PY1, alY, t, KB, VB, SB) do {                                                      \
        SBAR(); qkt<KB>(PX0, PX1, K_lds, r32, hi, S.qr, kbh + KBASE(t));                                                      \
        finishSM(PY0, PY1, alY, l_reg, pa0, pa1, pa2, pa3); SBAR();                                                           \
        if ((t) + 1 < NT) { SLOAD_H(Kh, Vh, KBASE((t) + 1)); SBAR(); }                                                        \
        pv_tile<VB, SK>(o, vb0, pa0, pa1, pa2, pa3, true); MASKT(PX0, PX1, (t)); partialSM(PX0, PX1, m_reg, mnX, alX);         \
        __syncthreads();                                                                                                      \
        if ((t) + 1 < NT) { VMW(); SWRITE_H(SB); }                                                                            \
        RESC(alX); __syncthreads(); } while (0)
    const int tf = NT >= 8 ? ((NT - 5) | 1) : -1;
    if (tf < 0 && tid == 0) cx.slot[0] = fox_fetch(cx.ctl);
    for (int t = 1; t + 1 < NT; t += 2) {
        if (t == tf && tid == 0) cx.slot[0] = fox_fetch(cx.ctl);
        HALF_STEP(pB0, pB1, mnB, alB, pA0, pA1, alA, t, 1, 0, 0);
        HALF_STEP(pA0, pA1, mnA, alA, pB0, pB1, alB, t + 1, 0, 1, 1);
    }
    const bool even = (NT & 1) == 0;
    if (even) { SBAR(); qkt<1>(pB0, pB1, K_lds, r32, hi, S.qr, kbh + KBASE(NT - 1)); SBAR(); }
    { const int n_nxt = __builtin_amdgcn_readfirstlane((int)cx.slot[0]);
      last = n_nxt >= 1024; if (last) nxt = cur; else nxt = fox_mkref(n_nxt, cx, lane); }
    SBAR();
    SLOAD_H(nxt.K, nxt.V, nxt.jlo * KVBLK); SBAR();
    { const bf16* qb_ = nxt.Q + (size_t)(wid * QBLK) * RS;
#pragma unroll
    for (int d0 = 0; d0 < 8; ++d0) S.qr[d0] = load8<bf16>(qb_ + qo + d0 * 16); }
    SBAR();
    finishSM(pA0, pA1, alA, l_reg, pa0, pa1, pa2, pa3); SBAR();
    pv_tile<0, SK>(o, vb0, pa0, pa1, pa2, pa3, true);
    if (even) { MASKT(pB0, pB1, NT - 1); partialSM(pB0, pB1, m_reg, mnB, alB); __syncthreads(); RESC(alB);
        finishSM(pB0, pB1, alB, l_reg, pa0, pa1, pa2, pa3); SBAR(); pv_tile<1, SK>(o, vb0, pa0, pa1, pa2, pa3, true); }
    SBAR(); SEAM_K0();
    if (hi == 0) li_l[r32] = l_reg; asm volatile("s_waitcnt lgkmcnt(0)" ::: "memory");
    float rli[16];
#pragma unroll
    for (int r = 0; r < 16; ++r) rli[r] = __builtin_amdgcn_rcpf(li_l[crow(r, hi)]);
    const size_t wofs = (size_t)(wid * QBLK) * RS; const bf16* gab = cur.GA + wofs; const bf16* obb = cur.OB + wofs; bf16* oub = cur.O + wofs;
    const unsigned eo = (unsigned)(hi * 4 * RS + r32);
    unsigned gav[2][2][4], obv[2][2][4];
#define EPI_LOAD(rg_) do { _Pragma("unroll") for (int rr = 0; rr < 2; ++rr) _Pragma("unroll") for (int d0 = 0; d0 < 4; ++d0) { const int r = (rg_) * 2 + rr, co = ((r & 3) + 8 * (r >> 2)) * RS + d0 * 32; \
        gav[(rg_) & 1][rr][d0] = ((const unsigned short*)(gab + co))[eo]; obv[(rg_) & 1][rr][d0] = ((const unsigned short*)(obb + co))[eo]; } } while (0)
    EPI_LOAD(0);
#pragma unroll
    for (int rg = 0; rg < 8; ++rg) {
        if (rg < 7) EPI_LOAD(rg + 1);
        SBAR();
#pragma unroll
        for (int rr = 0; rr < 2; ++rr)
#pragma unroll
            for (int d0 = 0; d0 < 4; ++d0) { const int r = rg * 2 + rr, co = ((r & 3) + 8 * (r >> 2)) * RS + d0 * 32;
                const float v = o[d0][r] * rli[r];
                const float m = __uint_as_float(gav[rg & 1][rr][d0] << 16) * v + __uint_as_float(obv[rg & 1][rr][d0] << 16);
                ((unsigned short*)(oub + co))[eo] = (unsigned short)(cvtpk(m, 0.f) & 0xffffu); }
        SBAR(); }
#undef EPI_LOAD
    __syncthreads();
#undef RESC
#undef KBASE
#undef MASKT
#undef SEAM_K0
#undef HALF_STEP
}
#undef ROW
#undef VMW
#undef VMWN
#undef SLOAD_H
#undef SWRITE_HK
#undef SWRITE_HV
#undef SWRITE_H
#undef SBAR
#undef KSWZ
}

#define LAS __attribute__((address_space(3)))
typedef unsigned short bf16u;
typedef unsigned v4u __attribute__((ext_vector_type(4)));
typedef float v4f __attribute__((ext_vector_type(4)));
typedef short v8s __attribute__((ext_vector_type(8)));
typedef float v16f __attribute__((ext_vector_type(16)));

constexpr int T = 32768, DM = 1024, FF = 4096, SEQ = 8192, NH = 8, INW = 7176;
constexpr float RMS_EPS = 1e-6f, LN_EPS = 1e-5f;
constexpr size_t MiB = 1u << 20;
constexpr size_t WS_RSTD0 = 0, WS_RSTD1 = 128 * 1024, WS_RSTD2 = 256 * 1024, WS_WF = 384 * 1024, WS_WSM = 512 * 1024, WS_LOGF = 1 * MiB, WS_KBIAS = 2 * MiB, WS_BAR = 3 * MiB, BAR_BYTES = 16384;
constexpr size_t WS_WGU1 = 4 * MiB, WS_WD1 = 20 * MiB, WS_WIN = 28 * MiB, WS_WOUT = 42 * MiB, WS_WGU2 = 44 * MiB, WS_WD2 = 60 * MiB;
constexpr size_t WS_R0 = 68 * MiB, WS_S0 = 132 * MiB, WS_S1 = 196 * MiB, WS_S2 = 260 * MiB, WS_S3 = 324 * MiB, WS_S4 = 388 * MiB, WS_END = 452 * MiB;
constexpr int LDS_TOTAL = 140 * 1024, LDS_MISC = 136 * 1024;

__device__ __forceinline__ unsigned f2bf(float f) { unsigned u = __builtin_bit_cast(unsigned, f); return (u + 0x7fffu + ((u >> 16) & 1u)) >> 16; }
__device__ __forceinline__ unsigned pk2(float lo, float hi) { return f2bf(lo) | (f2bf(hi) << 16); }
__device__ __forceinline__ float bflo(unsigned w) { return __uint_as_float(w << 16); }
__device__ __forceinline__ float bfhi(unsigned w) { return __uint_as_float(w & 0xffff0000u); }
template <int X> __device__ __forceinline__ float swz_xor(float v) { return __int_as_float(__builtin_amdgcn_ds_swizzle(__float_as_int(v), (X << 10) | 0x1f)); }
template <int CTRL> __device__ __forceinline__ float dpp_f(float v) { return __int_as_float(__builtin_amdgcn_update_dpp(0, __float_as_int(v), CTRL, 0xf, 0xf, false)); }
__device__ __forceinline__ float wave_sum(float v) {
    v += dpp_f<0xB1>(v); v += dpp_f<0x4E>(v); v += dpp_f<0x141>(v); v += dpp_f<0x140>(v); v += swz_xor<16>(v);
    auto rr = __builtin_amdgcn_permlane32_swap(__float_as_uint(v), __float_as_uint(v), false, false);
    return __uint_as_float(rr[0]) + __uint_as_float(rr[1]);
}

#define CAS __attribute__((address_space(4)))
#define XB_TMO      128
#define XB_XCNT(j)  (256  + 64 * (j))
#define XB_XSUB(j)  (1280 + 64 * (j))
#define XB_XGEN(j)  (2304 + 64 * (j))
#define XB_TOP      3328
#define XB_TOPGEN   3392
#define XCD_BAR_WORDS 3456
#define XB_SPIN_CAP (1u << 18)

__device__ __forceinline__ unsigned xb_ld(unsigned* p)              { return __hip_atomic_load(p, __ATOMIC_RELAXED, __HIP_MEMORY_SCOPE_AGENT); }
__device__ __forceinline__ unsigned xb_add(unsigned* p, unsigned v) { return __hip_atomic_fetch_add(p, v, __ATOMIC_RELAXED, __HIP_MEMORY_SCOPE_AGENT); }
__device__ __forceinline__ unsigned xb_xcc_id() { return (unsigned)__builtin_amdgcn_s_getreg((3 << 11) | 20) & 0xFu; }
#define XB_SPIN(cond, bar) do { unsigned _sp = 0; while (cond) { __builtin_amdgcn_s_sleep(1); \
    if ((++_sp & 255u) == 0u) { if (xb_ld(&(bar)[XB_TMO])) break; if (_sp > XB_SPIN_CAP) { atomicAdd(&(bar)[XB_TMO], 1u); break; } } } } while (0)

__device__ __forceinline__ void xcd_barrier_complete(unsigned* bar, unsigned x, unsigned& nloc, unsigned& nx) {
    const unsigned G = gridDim.x * gridDim.y * gridDim.z;
    unsigned sum, cnt, mine, sp = 0u;
    for (;;) {
        sum = 0u; cnt = 0u; mine = 0u;
#pragma unroll
        for (unsigned j = 0; j < 16; ++j) { const unsigned c = xb_ld(&bar[XB_XCNT(j)]); sum += c; cnt += (c > 0u) ? 1u : 0u; mine = (j == x) ? c : mine; }
        if (sum == G) break;
        __builtin_amdgcn_s_sleep(1);
        if ((++sp & 255u) == 0u) { if (xb_ld(&bar[XB_TMO])) break; if (sp > XB_SPIN_CAP) { atomicAdd(&bar[XB_TMO], 1u); break; } }
    }
    nloc = mine > 0u ? mine : 1u; nx = cnt > 0u ? cnt : 1u;
}
__device__ __forceinline__ void xcd_barrier(unsigned* bar, volatile LAS unsigned* st, bool leader) {
    asm volatile("s_waitcnt vmcnt(0)" ::: "memory");
    __syncthreads();
    if (leader) {
        const unsigned x = xb_xcc_id();
        __builtin_amdgcn_s_waitcnt(0);
        unsigned nloc = st[0], nx = st[1];
        if (nloc == 0u) { xcd_barrier_complete(bar, x, nloc, nx); st[0] = nloc; st[1] = nx; }
        const unsigned old = xb_add(&bar[XB_XSUB(x)], 1u);
        const unsigned gen = old / nloc;
        if (old + 1u == (gen + 1u) * nloc) {
            __builtin_amdgcn_fence(__ATOMIC_RELEASE, "agent");
            asm volatile("s_waitcnt vmcnt(0)" ::: "memory");
            const unsigned og = xb_add(&bar[XB_TOP], 1u);
            const unsigned tg = og / nx;
            if (og + 1u == (tg + 1u) * nx) xb_add(&bar[XB_TOPGEN], 1u);
            else XB_SPIN(xb_ld(&bar[XB_TOPGEN]) == tg, bar);
            __builtin_amdgcn_fence(__ATOMIC_ACQUIRE, "agent");
            xb_add(&bar[XB_XGEN(x)], 1u);
            asm volatile("s_waitcnt vmcnt(0)" ::: "memory");
        } else {
            XB_SPIN(xb_ld(&bar[XB_XGEN(x)]) == gen, bar);
            __builtin_amdgcn_fence(__ATOMIC_ACQUIRE, "agent");
            asm volatile("s_waitcnt vmcnt(0)" ::: "memory");
        }
    }
    __syncthreads();
}

struct Params {
    const float* x; const float* f1_pre_g; const float* f1_wg; const float* f1_wu; const float* f1_wd; const float* f1_post_g;
    const float* mix_pre_g; const float* w_in; const float* b_forget; const float* ln_g; const float* ln_b; const float* w_s; const float* b_s;
    const float* w_out; const float* mix_post_g; const float* f2_pre_g; const float* f2_wg; const float* f2_wu; const float* f2_wd; const float* f2_post_g;
    float* out; unsigned char* ws;
};

__device__ __forceinline__ void tr_item(const float* __restrict__ W, int ldn, int K, int scol, bf16u* WT, int drow, const float* __restrict__ g, LAS float* scr, int k0, int lane) {
    float v[32];
    const float* src = W + (size_t)(k0 + (lane >> 5)) * ldn + scol + (lane & 31);
#pragma unroll
    for (int i = 0; i < 32; ++i) v[i] = __builtin_nontemporal_load(src + (size_t)(2 * i) * ldn);
    const int c = lane & 7;
    v4f g0 = (v4f){1.f, 1.f, 1.f, 1.f}, g1 = g0;
    if (g) { g0 = *(const v4f*)(g + k0 + 8 * c); g1 = *(const v4f*)(g + k0 + 8 * c + 4); }
#pragma unroll
    for (int i = 0; i < 32; ++i) scr[(2 * i + (lane >> 5)) * 33 + (lane & 31)] = v[i];
    asm volatile("s_waitcnt lgkmcnt(0)" ::: "memory");
#pragma unroll
    for (int j = 0; j < 4; ++j) { const int n = (lane >> 3) + 8 * j; const LAS float* s = scr + (8 * c) * 33 + n;
        v4u o; o.x = pk2(s[0 * 33] * g0.x, s[1 * 33] * g0.y); o.y = pk2(s[2 * 33] * g0.z, s[3 * 33] * g0.w); o.z = pk2(s[4 * 33] * g1.x, s[5 * 33] * g1.y); o.w = pk2(s[6 * 33] * g1.z, s[7 * 33] * g1.w);
        *(v4u*)(WT + (size_t)(drow + n) * K + k0 + 8 * c) = o; }
    asm volatile("s_waitcnt lgkmcnt(0)" ::: "memory");
}

typedef const CAS Params* PP;
__device__ __forceinline__ int fresh_tid(int wave_s) { int t = 0; asm volatile("" : "+v"(t)); t = wave_s * 64 + (int)__builtin_amdgcn_mbcnt_hi(~0u, __builtin_amdgcn_mbcnt_lo(~0u, (unsigned)t)); asm volatile("" : "+v"(t)); return t;     }
__device__ __forceinline__ void p0_prologue(PP p, LAS unsigned char* lds, int gw, int NGW, int lane, int wave, int gtid, int NGT) {
    unsigned char* ws = p->ws;
    LAS float* scr = (LAS float*)(lds + wave * 16384);
    constexpr int I_G = 16 * 128, I_D = 64 * 32, I_IN = 16 * 224, I_O = 16 * 32;
    constexpr int NITEMS = 2 * (2 * I_G + I_D) + I_IN + I_O;
    for (int it = gw; it < NITEMS; it += NGW) {
        int r = it;
        if (r < 2 * I_G) { const bool up = r >= I_G; if (up) r -= I_G; const int kb = r >> 7, nb = r & 127, n0 = nb * 32;
            tr_item(up ? p->f1_wu : p->f1_wg, FF, DM, n0, (bf16u*)(ws + WS_WGU1), (n0 >> 7) * 256 + (n0 & 127) + (up ? 128 : 0), p->f1_pre_g, scr, kb * 64, lane); continue; }
        r -= 2 * I_G;
        if (r < I_D) { const int kb = r >> 5, nb = r & 31; tr_item(p->f1_wd, DM, FF, nb * 32, (bf16u*)(ws + WS_WD1), nb * 32, nullptr, scr, kb * 64, lane); continue; }
        r -= I_D;
        if (r < I_IN) { const int kb = r / 224, nb = r % 224, d0 = nb * 32;
            const int sc = d0 < 2048 ? d0 + 1024 : d0 < 3072 ? d0 - 2048 : d0 < 4096 ? 5128 + (d0 - 3072) : d0 < 5120 ? 3080 + (d0 - 4096) : d0 < 6144 ? 4104 + (d0 - 5120) : 6152 + (d0 - 6144);
            tr_item(p->w_in, INW, DM, sc, (bf16u*)(ws + WS_WIN), d0, p->mix_pre_g, scr, kb * 64, lane); continue; }
        r -= I_IN;
        if (r < I_O) { const int kb = r >> 5, nb = r & 31; tr_item(p->w_out, DM, DM, nb * 32, (bf16u*)(ws + WS_WOUT), nb * 32, nullptr, scr, kb * 64, lane); continue; }
        r -= I_O;
        if (r < 2 * I_G) { const bool up = r >= I_G; if (up) r -= I_G; const int kb = r >> 7, nb = r & 127, n0 = nb * 32;
            tr_item(up ? p->f2_wu : p->f2_wg, FF, DM, n0, (bf16u*)(ws + WS_WGU2), (n0 >> 7) * 256 + (n0 & 127) + (up ? 128 : 0), p->f2_pre_g, scr, kb * 64, lane); continue; }
        r -= 2 * I_G;
        { const int kb = r >> 5, nb = r & 31; tr_item(p->f2_wd, DM, FF, nb * 32, (bf16u*)(ws + WS_WD2), nb * 32, nullptr, scr, kb * 64, lane); }
    }
    float* Wf = (float*)(ws + WS_WF);
    for (int i = gtid; i < 8 * DM; i += NGT) { const int h = i >> 10, k = i & 1023; Wf[i] = p->w_in[(size_t)k * INW + 3072 + h] * p->mix_pre_g[k]; }
    bf16u* Wsm = (bf16u*)(ws + WS_WSM);
    for (int i = gtid; i < 8 * 128 * 128; i += NGT) { const int t = (i >> 7) & 127, s = i & 127; Wsm[i] = (bf16u)((s >> 6) <= (t >> 6) ? f2bf(p->w_s[i]) : 0u); }
    bf16u* xb = (bf16u*)(ws + WS_R0); float* rstd0 = (float*)(ws + WS_RSTD0);
    { v4f xv[2][4];
#define P0_LOAD(row0_) do { _Pragma("unroll") for (int n = 0; n < 2; ++n) { const float* xr_ = p->x + (size_t)((row0_) + n * NGW) * DM + 8 * lane; _Pragma("unroll") for (int j = 0; j < 2; ++j) { xv[n][2 * j] = __builtin_nontemporal_load((const v4f*)(xr_ + 512 * j)); xv[n][2 * j + 1] = __builtin_nontemporal_load((const v4f*)(xr_ + 512 * j + 4)); } } } while (0)
      if (gw < T) P0_LOAD(gw);
      for (int row = gw; row < T; row += 2 * NGW) {
        v4f v[2][4]; float ss[2];
#pragma unroll
        for (int n = 0; n < 2; ++n) { float s = 0.f;
#pragma unroll
            for (int j = 0; j < 4; ++j) { v[n][j] = xv[n][j]; s += (v[n][j].x * v[n][j].x + v[n][j].y * v[n][j].y) + (v[n][j].z * v[n][j].z + v[n][j].w * v[n][j].w); }
            ss[n] = s; }
        if (row + 2 * NGW < T) P0_LOAD(row + 2 * NGW);
#pragma unroll
        for (int n = 0; n < 2; ++n) ss[n] = wave_sum(ss[n]);
#pragma unroll
        for (int n = 0; n < 2; ++n) { const int rw = row + n * NGW;
            if (lane == 0) rstd0[rw] = 1.0f / sqrtf(ss[n] * (1.0f / DM) + RMS_EPS);
#pragma unroll
            for (int j = 0; j < 2; ++j) { v4u o; o.x = pk2(v[n][2 * j].x, v[n][2 * j].y); o.y = pk2(v[n][2 * j].z, v[n][2 * j].w); o.z = pk2(v[n][2 * j + 1].x, v[n][2 * j + 1].y); o.w = pk2(v[n][2 * j + 1].z, v[n][2 * j + 1].w);
                *(v4u*)(xb + (size_t)rw * DM + 8 * lane + 512 * j) = o; } }
      }
#undef P0_LOAD
    }
}

template <int NR> __device__ __forceinline__ void row_pass(const float* res, const bf16u* resb, const bf16u* y, const float* __restrict__ gpost, float alpha, float* xout, bf16u* xbo, float* rstd_out,
                                         const LAS float* Wf_l, const float* b_forget, float* logf, int gw, int NGW, int lane) {
    v4f g[4];
#pragma unroll
    for (int j = 0; j < 2; ++j) { g[2 * j] = *(const v4f*)(gpost + 8 * lane + 512 * j); g[2 * j + 1] = *(const v4f*)(gpost + 8 * lane + 512 * j + 4); }
    v4u yw[NR][2], qw[NR][2]; v4f rf[NR][4];
#define RP_LOAD(row0_) do { _Pragma("unroll") for (int n = 0; n < NR; ++n) { const size_t ro_ = (size_t)((row0_) + n * NGW) * DM + 8 * lane; _Pragma("unroll") for (int j = 0; j < 2; ++j) { yw[n][j] = *(const v4u*)(y + ro_ + 512 * j); \
        if (res) { rf[n][2 * j] = __builtin_nontemporal_load((const v4f*)(res + ro_ + 512 * j)); rf[n][2 * j + 1] = __builtin_nontemporal_load((const v4f*)(res + ro_ + 512 * j + 4)); } else qw[n][j] = *(const v4u*)(resb + ro_ + 512 * j); } } } while (0)
    if (gw < T) RP_LOAD(gw);
    for (int row = gw; row < T; row += NR * NGW) {
        v4f r[NR][4], yv[NR][4];
#pragma unroll
        for (int n = 0; n < NR; ++n)
#pragma unroll
            for (int j = 0; j < 2; ++j) { const v4u w = yw[n][j]; yv[n][2 * j] = (v4f){bflo(w.x), bfhi(w.x), bflo(w.y), bfhi(w.y)}; yv[n][2 * j + 1] = (v4f){bflo(w.z), bfhi(w.z), bflo(w.w), bfhi(w.w)};
                if (res) { r[n][2 * j] = rf[n][2 * j]; r[n][2 * j + 1] = rf[n][2 * j + 1]; }
                else { const v4u q = qw[n][j]; r[n][2 * j] = (v4f){bflo(q.x), bfhi(q.x), bflo(q.y), bfhi(q.y)}; r[n][2 * j + 1] = (v4f){bflo(q.z), bfhi(q.z), bflo(q.w), bfhi(q.w)}; } }
        if (row + NR * NGW < T) RP_LOAD(row + NR * NGW);
        float ss[NR];
#pragma unroll
        for (int n = 0; n < NR; ++n) { float s = 0.f;
#pragma unroll
            for (int j = 0; j < 4; ++j) s += (yv[n][j].x * yv[n][j].x + yv[n][j].y * yv[n][j].y) + (yv[n][j].z * yv[n][j].z + yv[n][j].w * yv[n][j].w);
            ss[n] = s; }
#pragma unroll
        for (int n = 0; n < NR; ++n) ss[n] = wave_sum(ss[n]);
#pragma unroll
        for (int n = 0; n < NR; ++n) { const float sc = alpha / sqrtf(ss[n] * (1.0f / DM) + RMS_EPS);
#pragma unroll
            for (int j = 0; j < 4; ++j) r[n][j] = r[n][j] + (yv[n][j] * sc) * g[j]; }
        if (xout) {
#pragma unroll
            for (int n = 0; n < NR; ++n) { const size_t ro = (size_t)(row + n * NGW) * DM + 8 * lane;
#pragma unroll
                for (int j = 0; j < 2; ++j) { __builtin_nontemporal_store(r[n][2 * j], (v4f*)(xout + ro + 512 * j)); __builtin_nontemporal_store(r[n][2 * j + 1], (v4f*)(xout + ro + 512 * j + 4)); } } }
        if (xbo) {
            float s2[NR], rs[NR];
#pragma unroll
            for (int n = 0; n < NR; ++n) { float s = 0.f;
#pragma unroll
                for (int j = 0; j < 4; ++j) s += (r[n][j].x * r[n][j].x + r[n][j].y * r[n][j].y) + (r[n][j].z * r[n][j].z + r[n][j].w * r[n][j].w);
                s2[n] = s; }
#pragma unroll
            for (int n = 0; n < NR; ++n) s2[n] = wave_sum(s2[n]);
#pragma unroll
            for (int n = 0; n < NR; ++n) { rs[n] = 1.0f / sqrtf(s2[n] * (1.0f / DM) + RMS_EPS); const size_t ro = (size_t)(row + n * NGW) * DM + 8 * lane;
                if (lane == 0) rstd_out[row + n * NGW] = rs[n];
#pragma unroll
                for (int j = 0; j < 2; ++j) { v4u o; o.x = pk2(r[n][2 * j].x, r[n][2 * j].y); o.y = pk2(r[n][2 * j].z, r[n][2 * j].w); o.z = pk2(r[n][2 * j + 1].x, r[n][2 * j + 1].y); o.w = pk2(r[n][2 * j + 1].z, r[n][2 * j + 1].w);
                    *(v4u*)(xbo + ro + 512 * j) = o; } }
            if (logf) {
#pragma unroll
                for (int n = 0; n < NR; ++n) {
                    float d8[8];
#pragma unroll
                    for (int h = 0; h < 8; ++h) { const LAS float* wf = Wf_l + h * DM + 8 * lane; float d = 0.f;
#pragma unroll
                        for (int j = 0; j < 2; ++j) { const v4f a = *(const LAS v4f*)(wf + 512 * j), b = *(const LAS v4f*)(wf + 512 * j + 4);
                            d += (r[n][2 * j].x * a.x + r[n][2 * j].y * a.y) + (r[n][2 * j].z * a.z + r[n][2 * j].w * a.w) + (r[n][2 * j + 1].x * b.x + r[n][2 * j + 1].y * b.y) + (r[n][2 * j + 1].z * b.z + r[n][2 * j + 1].w * b.w); }
                        d8[h] = d; }
#pragma unroll
                    for (int h = 0; h < 8; ++h) d8[h] += dpp_f<0xB1>(d8[h]);
#pragma unroll
                    for (int h = 0; h < 8; ++h) d8[h] += dpp_f<0x4E>(d8[h]);
#pragma unroll
                    for (int h = 0; h < 8; ++h) d8[h] += dpp_f<0x141>(d8[h]);
#pragma unroll
                    for (int h = 0; h < 8; ++h) d8[h] += dpp_f<0x140>(d8[h]);
#pragma unroll
                    for (int h = 0; h < 8; ++h) d8[h] += swz_xor<16>(d8[h]);
#pragma unroll
                    for (int h = 0; h < 8; ++h) { auto rr = __builtin_amdgcn_permlane32_swap(__float_as_uint(d8[h]), __float_as_uint(d8[h]), false, false); d8[h] = __uint_as_float(rr[0]) + __uint_as_float(rr[1]); }
                    float dsel = d8[0];
#pragma unroll
                    for (int h = 1; h < 8; ++h) dsel = lane == h ? d8[h] : dsel;
                    if (lane < 8) { const float z = dsel * rs[n] + b_forget[lane]; const float ls = fminf(z, 0.f) - log1pf(expf(-fabsf(z))); logf[(size_t)lane * T + row + n * NGW] = ls; }
                }
            }
        }
    }
}

#undef RP_LOAD
__device__ __forceinline__ void cumsum_phase(const float* logf, float* kbias, LAS unsigned char* lds, int bx, int tid, int lane, int wave) {
    if (bx < 32) {
        const int b = bx >> 3, h = bx & 7; LAS float* wt = (LAS float*)lds;
        float v[16]; float run = 0.f;
#pragma unroll
        for (int i = 0; i < 16; ++i) { run += logf[(size_t)h * T + (size_t)b * SEQ + tid * 16 + i]; v[i] = run; }
        float incl = run;
#pragma unroll
        for (int o = 1; o < 64; o <<= 1) { const float t = __int_as_float(__builtin_amdgcn_ds_bpermute(((lane - o) & 63) << 2, __float_as_int(incl))); if (lane >= o) incl += t; }
        if (lane == 63) wt[wave] = incl;
        __syncthreads();
        float base = incl - run;
        for (int w = 0; w < wave; ++w) base += wt[w];
#pragma unroll
        for (int i = 0; i < 16; ++i) kbias[(size_t)bx * SEQ + tid * 16 + i] = -(base + v[i]) * 11.313708498984761f;
    }
    __syncthreads();
}

__device__ __forceinline__ void sgu_phase(PP p, LAS unsigned char* lds, bf16u* U, const bf16u* SV, const bf16u* GB, const bf16u* Wsm, int G, int bx, int tid, int lane, int wave) {
    LAS bf16u* vnT = (LAS bf16u*)lds;
    const int r32 = lane & 31, hi = lane >> 5;
    for (int unit = bx; unit < 2048; unit += G) {
        const int g = unit & 7, win = unit >> 3; const size_t row0 = (size_t)win * 128; const int col0 = g * 128;
        const int tb = (wave & 3) * 32, cbw = (wave >> 2) * 64;
        unsigned short uu[16][2], gg[16][2]; float bsv[16];
            bf16u* ub = U + (row0 + tb) * DM + col0 + cbw; const bf16u* gbp = GB + (row0 + tb) * DM + col0 + cbw; const float* bsp = p->b_s + g * 128 + tb;
            const unsigned eo = (unsigned)(hi * 4 * DM + r32);
#pragma unroll
            for (int r = 0; r < 16; ++r) { const int tc = (r & 3) + 8 * (r >> 2), co = tc * DM; bsv[r] = bsp[tc + 4 * hi];
                uu[r][0] = (ub + co)[eo]; uu[r][1] = (ub + co + 32)[eo]; gg[r][0] = (gbp + co)[eo]; gg[r][1] = (gbp + co + 32)[eo]; }
        { const int r = tid >> 2, q = tid & 3; const bf16u* src = (SV + row0 * DM + col0) + (unsigned)(r * DM + q * 32);
            float v[32];
#pragma unroll
            for (int i = 0; i < 4; ++i) { const v4u w = *(const v4u*)(src + 8 * i);
                v[8 * i] = bflo(w.x); v[8 * i + 1] = bfhi(w.x); v[8 * i + 2] = bflo(w.y); v[8 * i + 3] = bfhi(w.y); v[8 * i + 4] = bflo(w.z); v[8 * i + 5] = bfhi(w.z); v[8 * i + 6] = bflo(w.w); v[8 * i + 7] = bfhi(w.w); }
            float s = 0.f;
#pragma unroll
            for (int i = 0; i < 32; ++i) s += v[i];
            s += swz_xor<1>(s); s += swz_xor<2>(s);
            const float mu = s * (1.0f / 128.0f); float q2 = 0.f;
#pragma unroll
            for (int i = 0; i < 32; ++i) { v[i] -= mu; q2 += v[i] * v[i]; }
            q2 += swz_xor<1>(q2); q2 += swz_xor<2>(q2);
            const float rs = 1.0f / sqrtf(q2 * (1.0f / 128.0f) + LN_EPS);
            const float* lg = p->ln_g + col0 + q * 32; const float* lb = p->ln_b + col0 + q * 32;
#pragma unroll
            for (int i = 0; i < 32; ++i) vnT[(q * 32 + i) * 136 + r] = (bf16u)f2bf(v[i] * rs * lg[i] + lb[i]);
        }
        v8s afr[8];
        { const bf16u* wa = Wsm + ((size_t)(g * 128 + tb + r32)) * 128 + 8 * hi;
#pragma unroll
          for (int kk = 0; kk < 8; ++kk) afr[kk] = *(const v8s*)(wa + 16 * kk); }
        __syncthreads();
        v16f acc0 = {}, acc1 = {};
        const LAS bf16u* vb0 = vnT + (cbw + r32) * 136 + 8 * hi; const LAS bf16u* vb1 = vb0 + 32 * 136;
#pragma unroll
        for (int kk = 0; kk < 8; ++kk) { const v8s a = afr[kk]; const v8s b0 = *(const LAS v8s*)(vb0 + 16 * kk), b1 = *(const LAS v8s*)(vb1 + 16 * kk);
            acc0 = __builtin_amdgcn_mfma_f32_32x32x16_bf16(a, b0, acc0, 0, 0, 0); acc1 = __builtin_amdgcn_mfma_f32_32x32x16_bf16(a, b1, acc1, 0, 0, 0); }
        {
            __builtin_amdgcn_sched_barrier(0);
#pragma unroll
            for (int r = 0; r < 16; ++r) { const int co = ((r & 3) + 8 * (r >> 2)) * DM;
                const float u0 = __uint_as_float((unsigned)uu[r][0] << 16), u1 = __uint_as_float((unsigned)uu[r][1] << 16), g0 = __uint_as_float((unsigned)gg[r][0] << 16), g1 = __uint_as_float((unsigned)gg[r][1] << 16);
                (ub + co)[eo] = (bf16u)f2bf(g0 * u0 * (acc0[r] + bsv[r])); (ub + co + 32)[eo] = (bf16u)f2bf(g1 * u1 * (acc1[r] + bsv[r])); } }
        __syncthreads();
    }
}

__device__ __forceinline__ void attn_phase(unsigned char* lds_g, LAS unsigned char* lds, bf16u* Qb, const bf16u* Kb, const bf16u* Vb, const bf16u* GAb, const bf16u* OBb, const float* kbias, unsigned* ctl, int wave_s) {
    const LAS float* kbl = (const LAS float*)(lds + att::KB_OFF);
    att::FoxCtx cx; cx.Qb = Qb; cx.Kb = Kb; cx.Vb = Vb; cx.GAb = GAb; cx.OBb = OBb; cx.kbias = kbias; cx.ctl = ctl; cx.slot = (volatile LAS unsigned*)(lds + LDS_MISC + 16);
    int tid = fresh_tid(wave_s);
    if (tid == 0) cx.slot[0] = att::fox_fetch(ctl);
    __syncthreads();
    const int n_cur = __builtin_amdgcn_readfirstlane((int)cx.slot[0]);
    __syncthreads();
    if (n_cur >= 1024) return;
    att::BlockRef cur = att::fox_mkref(n_cur, cx, tid & 63);
    att::Seam S;
    bool first = true;
    for (;;) {
        tid = fresh_tid(wave_s);
        { const float* kbg = kbias + (size_t)cur.bh * SEQ; LAS float* kw = (LAS float*)(lds + att::KB_OFF); const int n = cur.P0 + 256;
            for (int i = cur.jlo * 64 + tid * 4; i < n; i += 2048) *(LAS v4f*)(kw + i) = *(const v4f*)(kbg + i);
            __syncthreads(); }
        if (first) { att::fox_prime(cur, (char*)lds_g, S, wave_s); first = false; }
        att::BlockRef nxt; bool last;
        att::fox_block(cur, nxt, last, cx, (char*)lds_g, kbl, S, wave_s);
        if (last) break;
        cur = nxt;
    }
}

#ifndef DOUBLE_STEP
#define DOUBLE_STEP -1
#endif
__global__ void __launch_bounds__(512, 2) fox_gmlp_fwd(Params p_unused) {
    extern __shared__ __attribute__((aligned(16))) unsigned char lds_raw[];
    cg::grid_group grid = cg::this_grid();
    LAS unsigned char* lds = (LAS unsigned char*)lds_raw;
    const int G = gridDim.x, bx = blockIdx.x, NGW = G * 8, NGT = G * 512;
    const int wave_s = __builtin_amdgcn_readfirstlane((int)threadIdx.x >> 6);
    volatile LAS unsigned* bst = (volatile LAS unsigned*)(lds + LDS_MISC);
    if (threadIdx.x < 2) bst[threadIdx.x] = 0u;
    grid.sync();
    { PP p0 = (PP)__builtin_amdgcn_kernarg_segment_ptr(); if (threadIdx.x == 0) (void)xb_add((unsigned*)(p0->ws + WS_BAR) + XB_XCNT(xb_xcc_id()), 1u); }
#pragma unroll 1
    for (int it = 0; it < 13 + (DOUBLE_STEP >= 0 ? 1 : 0); ++it) {
        const int step = (DOUBLE_STEP >= 0 && it > DOUBLE_STEP) ? it - 1 : it;
        const int tid = fresh_tid(wave_s);
        const int lane = tid & 63, wave = wave_s, gw = bx * 8 + wave, gtid = bx * 512 + tid;
        PP p = (PP)__builtin_amdgcn_kernarg_segment_ptr(); asm volatile("" : "+s"(p));
        unsigned char* ws = p->ws;
        bf16u* R0 = (bf16u*)(ws + WS_R0); bf16u* S0 = (bf16u*)(ws + WS_S0); bf16u* S1 = (bf16u*)(ws + WS_S1); bf16u* S2 = (bf16u*)(ws + WS_S2); bf16u* S3 = (bf16u*)(ws + WS_S3); bf16u* S4 = (bf16u*)(ws + WS_S4);
        float* rstd0 = (float*)(ws + WS_RSTD0); float* rstd1 = (float*)(ws + WS_RSTD1); float* rstd2 = (float*)(ws + WS_RSTD2);
        float* logf = (float*)(ws + WS_LOGF); float* kbias = (float*)(ws + WS_KBIAS);
        if (step == 0) {
            p0_prologue(p, lds, gw, NGW, lane, wave, gtid, NGT);
        } else if (step == 1 || step == 10) {
            const bool second = step == 10;
            pg8::Gemm g{R0, (const bf16u*)(ws + (second ? WS_WGU2 : WS_WGU1)), T, 2 * FF, DM}; pg8::StaticOrder S; S.init(T, 2 * FF, G, bx);
            pg8::EpiSwiGLU E{S0, second ? rstd2 : rstd0};
            pg8::gemm_phase<pg8::EpiSwiGLU, pg8::StaticOrder, true, true>(lds, g, S, E, wave_s);
        } else if (step == 2 || step == 8 || step == 11) {
            const bf16u* A = step == 8 ? S3 : S0; const bf16u* Bt = (const bf16u*)(ws + (step == 2 ? WS_WD1 : step == 8 ? WS_WOUT : WS_WD2));
            bf16u* Y = step == 8 ? S0 : S4; const int K = step == 8 ? DM : FF;
            pg8::Gemm g{A, Bt, T, DM, K}; pg8::StaticOrder S; S.init(T, DM, G, bx);
            pg8::EpiBf16<0> E{Y, DM, nullptr, 0, 0, 1.f};
            pg8::gemm_phase<pg8::EpiBf16<0>, pg8::StaticOrder, true, true>(lds, g, S, E, wave_s);
        } else if (step == 3 || step == 9 || step == 12) {
            if (step == 3) {
                LAS float* wfl = (LAS float*)lds; const float* Wf = (const float*)(ws + WS_WF);
                for (int i = tid * 4; i < 8 * DM; i += 2048) *(LAS v4f*)(wfl + i) = *(const v4f*)(Wf + i);
                __syncthreads();
                row_pass<1>(p->x, nullptr, S4, p->f1_post_g, 0.5f, nullptr, R0, rstd1, wfl, p->b_forget, logf, gw, NGW, lane);
            } else if (step == 9) {
                row_pass<2>(nullptr, R0, S0, p->mix_post_g, 1.0f, nullptr, R0, rstd2, nullptr, nullptr, nullptr, gw, NGW, lane);
            } else {
                row_pass<2>(nullptr, R0, S4, p->f2_post_g, 0.5f, p->out, nullptr, nullptr, nullptr, nullptr, nullptr, gw, NGW, lane);
            }
        } else if (step == 4 || step == 6) {
            if (step == 4) cumsum_phase(logf, kbias, lds, bx, tid, lane, wave);
            const bool a = step == 4;
            pg8::Gemm g{R0, (const bf16u*)(ws + WS_WIN) + (a ? (size_t)4096 * DM : 0), T, a ? 3072 : 4096, DM}; pg8::StaticOrder S; S.init(T, a ? 3072 : 4096, G, bx);
            pg8::EpiMix E{a ? S0 : S1, (size_t)32 * MiB, a ? 0 : 1, rstd1, (unsigned*)(ws + WS_BAR) + att::CW_NRM};
            pg8::gemm_phase<pg8::EpiMix, pg8::StaticOrder, true, true>(lds, g, S, E, wave_s);
        } else if (step == 5) {
            sgu_phase(p, lds, S0, S1, S2, (const bf16u*)(ws + WS_WSM), G, bx, tid, lane, wave);
        } else if (step == 7) {
            attn_phase(lds_raw, lds, S3, S1, S2, S4, S0, kbias, (unsigned*)(ws + WS_BAR), wave_s);
        }
        if (it != 12 + (DOUBLE_STEP >= 0 ? 1 : 0)) xcd_barrier((unsigned*)(ws + WS_BAR), bst, wave_s == 0 && lane == 0);
    }
}

extern "C" void kernel_launch(void* const* d_in, const int* in_sizes, int n_in, void* d_out, int out_size, void* d_ws, size_t ws_size, hipStream_t stream) {
    static int grid = 0;
    if (grid == 0) {
        if (n_in != 20 || in_sizes[0] != T * DM || out_size != T * DM || ws_size < WS_END) {
            fprintf(stderr, "kernel_launch: unexpected shapes (n_in %d, in0 %d, out %d, ws %zu); nothing launched\n", n_in, n_in > 0 ? in_sizes[0] : -1, out_size, ws_size); grid = -1; return; }
        int dev = 0, cus = 0, per_cu = 0;
        (void)hipGetDevice(&dev); (void)hipDeviceGetAttribute(&cus, hipDeviceAttributeMultiprocessorCount, dev);
        if (hipFuncSetAttribute((const void*)fox_gmlp_fwd, hipFuncAttributeMaxDynamicSharedMemorySize, LDS_TOTAL) != hipSuccess) { fprintf(stderr, "kernel_launch: hipFuncSetAttribute failed\n"); grid = -1; return; }
        if (hipOccupancyMaxActiveBlocksPerMultiprocessor(&per_cu, (const void*)fox_gmlp_fwd, 512, LDS_TOTAL) != hipSuccess || per_cu < 1) { fprintf(stderr, "kernel_launch: occupancy query says %d\n", per_cu); per_cu = 1; }
        (void)hipGetLastError();
        if (per_cu > 1) per_cu = 1;
        grid = cus * per_cu;
    }
    if (grid < 0) return;
    Params p{};
    p.x = (const float*)d_in[0]; p.f1_pre_g = (const float*)d_in[1]; p.f1_wg = (const float*)d_in[2]; p.f1_wu = (const float*)d_in[3]; p.f1_wd = (const float*)d_in[4]; p.f1_post_g = (const float*)d_in[5];
    p.mix_pre_g = (const float*)d_in[6]; p.w_in = (const float*)d_in[7]; p.b_forget = (const float*)d_in[8]; p.ln_g = (const float*)d_in[9]; p.ln_b = (const float*)d_in[10]; p.w_s = (const float*)d_in[11]; p.b_s = (const float*)d_in[12];
    p.w_out = (const float*)d_in[13]; p.mix_post_g = (const float*)d_in[14]; p.f2_pre_g = (const float*)d_in[15]; p.f2_wg = (const float*)d_in[16]; p.f2_wu = (const float*)d_in[17]; p.f2_wd = (const float*)d_in[18]; p.f2_post_g = (const float*)d_in[19];
    p.out = (float*)d_out; p.ws = (unsigned char*)d_ws;
    if (hipMemsetAsync((char*)d_ws + WS_BAR, 0, BAR_BYTES, stream) != hipSuccess) { fprintf(stderr, "kernel_launch: hipMemsetAsync failed\n"); return; }
    void* args[] = {&p};
    hipError_t e = hipLaunchCooperativeKernel((const void*)fox_gmlp_fwd, dim3(grid), dim3(512), args, LDS_TOTAL, stream);
    if (e != hipSuccess) fprintf(stderr, "kernel_launch: cooperative launch failed: %s (grid %d)\n", hipGetErrorString(e), grid);
}
```
